# Optimizing an MI355X kernel written in HIP

```python
import jax, jax.numpy as jnp
from jax import lax
import numpy as np

D_MODEL = 1024
BATCH = 8
SEQ = 4096
DEPTH = 1

CHUNK = 64
Q_BLOCK = 64
D_CONV = D_MODEL // 2
CONV_WIDTH = 31
N_HEADS = 8
HEAD_DIM = 64
D_ATTN = N_HEADS * HEAD_DIM
N_IDX_HEADS = 8
IDX_DIM = 64
TOPK_MAX = 256
D_FF = 4 * D_MODEL
N_BRANCHES = 2
ROPE_THETA = 10000.0
LN_EPS = 1e-5
NEG_INF = -1e30
DEEPNORM_ALPHA = (2.0 * DEPTH) ** 0.25
DEEPNORM_BETA = (8.0 * DEPTH) ** -0.25
IN_SPLIT_SIZES = (D_CONV, D_CONV, D_ATTN, D_ATTN, D_ATTN,
                  N_IDX_HEADS * IDX_DIM, IDX_DIM, N_IDX_HEADS, D_MODEL, D_MODEL)
D_IN = sum(IN_SPLIT_SIZES)

kernel_name = "hybrid_conformer_conv_dsa_gated_deepnorm"


def layer_norm(x, g, b):
    xf = x.astype(jnp.float32)
    mu = jnp.mean(xf, axis=-1, keepdims=True)
    var = jnp.mean(jnp.square(xf - mu), axis=-1, keepdims=True)
    return ((xf - mu) * lax.rsqrt(var + LN_EPS) * g.astype(jnp.float32)
            + b.astype(jnp.float32)).astype(x.dtype)


def rope(x, pos):
    d = x.shape[-1]
    inv_freq = ROPE_THETA ** (-jnp.arange(0, d, 2, dtype=jnp.float32) / d)
    ang = pos.astype(jnp.float32)[:, None] * inv_freq[None, :]
    cos = jnp.cos(ang)[:, None, :]
    sin = jnp.sin(ang)[:, None, :]
    xf = x.astype(jnp.float32)
    x1, x2 = xf[..., : d // 2], xf[..., d // 2:]
    return jnp.concatenate([x1 * cos - x2 * sin, x2 * cos + x1 * sin], axis=-1).astype(x.dtype)


def conformer_conv_branch(a, b, dw_w, dw_b, ln_g, ln_b, w_out):
    u = a * jax.nn.sigmoid(b)
    u = lax.conv_general_dilated(
        u, dw_w[:, None, :].astype(u.dtype), window_strides=(1,),
        padding=[(CONV_WIDTH - 1, 0)],
        dimension_numbers=('NWC', 'WIO', 'NWC'),
        feature_group_count=D_CONV) + dw_b
    u = jax.nn.silu(layer_norm(u, ln_g, ln_b))
    return u @ w_out


def dsa_sparse_attention(q, k, v, qi, ki, wi, pos):
    B, L = q.shape[0], q.shape[1]
    dt = q.dtype
    topk = min(TOPK_MAX, L // 4)
    n_blk = L // Q_BLOCK
    key_chunk = pos // CHUNK
    ki_f = ki.astype(jnp.float32)
    kv = jnp.concatenate([k, v], axis=-1)

    def to_blocks(t):
        return t.reshape(B, n_blk, Q_BLOCK, *t.shape[2:]).swapaxes(0, 1)

    def attend_block(args):
        qb, qib, wb, start = args
        q_chunk = (start + jnp.arange(Q_BLOCK)) // CHUNK
        admissible = key_chunk[None, :] <= q_chunk[:, None]
        logits = jnp.einsum('bqhd,bsd->bqhs', qib.astype(jnp.float32), ki_f) * (IDX_DIM ** -0.5)
        iscore = jnp.einsum('bqhs,bqh->bqs', jax.nn.relu(logits), wb.astype(jnp.float32))
        iscore = jnp.where(admissible[None], iscore, NEG_INF)
        _, idx = lax.top_k(iscore, topk)
        valid = (idx // CHUNK) <= q_chunk[None, :, None]
        kv_sel = jax.vmap(lambda kvb, ib: kvb[ib])(kv, idx)
        k_sel, v_sel = jnp.split(kv_sel, 2, axis=-1)
        s = jnp.einsum('bqhd,bqkhd->bhqk', qb.astype(jnp.float32),
                       k_sel.astype(jnp.float32)) * (HEAD_DIM ** -0.5)
        s = jnp.where(valid[:, None], s, NEG_INF)
        p = jax.nn.softmax(s, axis=-1).astype(dt)
        return jnp.einsum('bhqk,bqkhd->bqhd', p, v_sel)

    starts = jnp.arange(n_blk, dtype=jnp.int32) * Q_BLOCK
    o = lax.map(attend_block, (to_blocks(q), to_blocks(qi), to_blocks(wi), starts))
    return o.swapaxes(0, 1).reshape(B, L, N_HEADS * HEAD_DIM)


def setup_inputs(seed: int = 0) -> dict:
    key = jax.random.key(seed)
    ks = jax.random.split(key, 20)
    f32 = jnp.float32

    def nrm(k, shape, scale):
        return jax.random.normal(k, shape, f32) * scale

    def gain(k, n):
        return 1.0 + 0.05 * jax.random.normal(k, (DEPTH, n), f32)

    return {
        "x": jax.random.normal(ks[0], (BATCH, SEQ, D_MODEL), f32),
        "w_in": nrm(ks[1], (DEPTH, D_MODEL, D_IN), D_MODEL ** -0.5),
        "dw_w": nrm(ks[2], (DEPTH, CONV_WIDTH, D_CONV), CONV_WIDTH ** -0.5),
        "dw_b": nrm(ks[3], (DEPTH, D_CONV), 0.02),
        "conv_ln_g": gain(ks[4], D_CONV),
        "conv_ln_b": nrm(ks[5], (DEPTH, D_CONV), 0.02),
        "w_conv_out": nrm(ks[6], (DEPTH, D_CONV, D_MODEL), D_CONV ** -0.5),
        "idx_k_ln_g": gain(ks[7], IDX_DIM),
        "idx_k_ln_b": nrm(ks[8], (DEPTH, IDX_DIM), 0.02),
        "w_attn_out": nrm(ks[9], (DEPTH, D_ATTN, D_MODEL), D_ATTN ** -0.5),
        "gate_b": nrm(ks[10], (DEPTH, N_BRANCHES, D_MODEL), 0.02),
        "w_out": nrm(ks[11], (DEPTH, D_MODEL, D_MODEL), DEEPNORM_BETA * D_MODEL ** -0.5),
        "ln1_g": gain(ks[12], D_MODEL),
        "ln1_b": nrm(ks[13], (DEPTH, D_MODEL), 0.02),
        "w_ff_in": nrm(ks[14], (DEPTH, D_MODEL, D_FF), D_MODEL ** -0.5),
        "w_ff_out": nrm(ks[15], (DEPTH, D_FF, D_MODEL), DEEPNORM_BETA * D_FF ** -0.5),
        "ln2_g": gain(ks[16], D_MODEL),
        "ln2_b": nrm(ks[17], (DEPTH, D_MODEL), 0.02),
    }


def reference(x, w_in, dw_w, dw_b, conv_ln_g, conv_ln_b, w_conv_out, idx_k_ln_g, idx_k_ln_b,
              w_attn_out, gate_b, w_out, ln1_g, ln1_b, w_ff_in, w_ff_out, ln2_g, ln2_b):
    B, L, _ = x.shape
    pos = jnp.arange(L, dtype=jnp.int32)
    split_points = np.cumsum(np.array(IN_SPLIT_SIZES))[:-1].tolist()
    for layer in range(DEPTH):
        proj = x @ w_in[layer]
        (conv_a, conv_b, q, k, v, qi, ki, wi, g_conv, g_attn) = jnp.split(proj, split_points, axis=-1)

        conv_out = conformer_conv_branch(conv_a, conv_b, dw_w[layer], dw_b[layer],
                                         conv_ln_g[layer], conv_ln_b[layer], w_conv_out[layer])

        q = rope(q.reshape(B, L, N_HEADS, HEAD_DIM), pos)
        k = rope(k.reshape(B, L, N_HEADS, HEAD_DIM), pos)
        v = v.reshape(B, L, N_HEADS, HEAD_DIM)
        qi = rope(qi.reshape(B, L, N_IDX_HEADS, IDX_DIM), pos)
        ki = rope(layer_norm(ki, idx_k_ln_g[layer], idx_k_ln_b[layer])[:, :, None, :], pos)[:, :, 0, :]
        wi = wi * (N_IDX_HEADS ** -0.5)
        attn = dsa_sparse_attention(q, k, v, qi, ki, wi, pos)
        attn_out = attn @ w_attn_out[layer]

        merged = (jax.nn.sigmoid(g_conv + gate_b[layer, 0]) * conv_out
                  + jax.nn.sigmoid(g_attn + gate_b[layer, 1]) * attn_out)
        mixer = merged @ w_out[layer]
        x = layer_norm(DEEPNORM_ALPHA * x + mixer, ln1_g[layer], ln1_b[layer])

        h = jnp.square(jax.nn.relu(x @ w_ff_in[layer]))
        x = layer_norm(DEEPNORM_ALPHA * x + h @ w_ff_out[layer], ln2_g[layer], ln2_b[layer])
    return x
```

```cpp
#include <hip/hip_runtime.h>
#include <hip/hip_cooperative_groups.h>
#include <cstdio>
#include <cstdint>
namespace cg = cooperative_groups;
namespace pg8 {
#define PG8_LAS __attribute__((address_space(3)))
typedef unsigned short bf16_t;
typedef short bf16x8 __attribute__((ext_vector_type(8)));
typedef float f32x4 __attribute__((ext_vector_type(4)));
typedef unsigned u32x4 __attribute__((ext_vector_type(4)));
constexpr int BM = 256, BK = 64, HALF = 128, HTB = HALF * BK * 2  , STAGE_BYTES = 8 * HTB, NXCD = 8, WGM = 8;

__host__ __device__ __forceinline__ int lds_byte(int r, int c) { const int st = (r >> 4) * 2 + (c >> 5), rr = r & 15, cc = c & 31, ob = rr * 64 + cc * 2; return st * 1024 + (ob ^ (((ob >> 9) & 1) << 5)); }
__host__ __device__ __forceinline__ void stage_rc(int b, int& R, int& C) { const int st = b / 1024, sb = b % 1024, swz = sb ^ (((sb >> 9) & 1) << 5); R = (st >> 1) * 16 + swz / 64; C = (st & 1) * 32 + (swz % 64) / 2; }
__host__ __device__ __forceinline__ int perm32(int rho) { const int n = rho >> 4, i = rho & 15; return 8 * (i >> 2) + 4 * n + (i & 3); }

struct Unit { int pm, pn; };
struct Gemm { const bf16_t* A; const bf16_t* Bt; int M, N, K; };

struct StaticOrder {
    int nM, nN, nwg, G, c;
    __host__ __device__ void init(int M, int N, int G_, int c_) { nM = M / BM; nN = N / BM; nwg = nM * nN; G = G_; c = c_; }
    __host__ __device__ bool next(int i, Unit& u) const {
        const long L = (long)i * G + c; if (L >= nwg) return false;
        int wgid = (int)L; { const int q = nwg / NXCD, r = nwg % NXCD, xcd = wgid % NXCD, off = wgid / NXCD; wgid = (xcd < r ? xcd * (q + 1) : r * (q + 1) + (xcd - r) * q) + off; }
        const int nig = WGM * nN, gid = wgid / nig, fm = gid * WGM, gsz = (nM - fm) < WGM ? (nM - fm) : WGM;
        u.pm = fm + ((wgid % nig) % gsz); u.pn = (wgid % nig) / gsz; return true;
    }
    __device__ __forceinline__ void a_ready(const Unit&) const {}
    __device__ __forceinline__ void done(const Unit&) const {}
};

__device__ __forceinline__ unsigned cvt_pk_bf16(float lo, float hi) { unsigned r; asm volatile("v_cvt_pk_bf16_f32 %0, %1, %2" : "=v"(r) : "v"(lo), "v"(hi)); return r; }
typedef float f32x2 __attribute__((ext_vector_type(2)));
typedef unsigned u32x2 __attribute__((ext_vector_type(2)));
__device__ __forceinline__ float bfbits2f(unsigned short b) { return __builtin_bit_cast(float, (unsigned)b << 16); }
__device__ __forceinline__ float sigmoidf_(float v) { return __builtin_amdgcn_rcpf(1.0f + __builtin_amdgcn_exp2f(-1.4426950408889634f * v)); }
template <int ACT> struct EpiBf16 {
    static constexpr bool PERM = true, AFTER_DRAIN = false;
    bf16_t* O; int ldc;
    __device__ __forceinline__ void operator()(const f32x4 (&acc)[2][2][4][2], const Unit& u, int wr, int wc, int fr, int fq) const {
        const int row0 = u.pm * BM + wr * 64 + fr; const int col0 = u.pn * BM + wc * 32 + 8 * fq;
#pragma unroll
        for (int ai = 0; ai < 2; ++ai)
#pragma unroll
            for (int m = 0; m < 4; ++m) { bf16_t* rowp = O + (size_t)(row0 + ai * HALF + m * 16) * ldc + col0;
#pragma unroll
                for (int bj = 0; bj < 2; ++bj) { f32x4 v0 = acc[ai][bj][m][0], v1 = acc[ai][bj][m][1];
                    if (ACT == 2) {
#pragma unroll
                        for (int i = 0; i < 4; ++i) { float a = __builtin_fmaxf(v0[i], 0.f), b = __builtin_fmaxf(v1[i], 0.f); v0[i] = a * a; v1[i] = b * b; } }
                    u32x4 w; w.x = cvt_pk_bf16(v0[0], v0[1]); w.y = cvt_pk_bf16(v0[2], v0[3]); w.z = cvt_pk_bf16(v1[0], v1[1]); w.w = cvt_pk_bf16(v1[2], v1[3]);
                    *(u32x4*)(rowp + bj * HALF) = w; } }
    }
};
struct EpiGate1 {
    static constexpr bool PERM = false, AFTER_DRAIN = false;
    float* T; const bf16_t* G; int ldg; const float* gb;
    __device__ __forceinline__ void operator()(const f32x4 (&acc)[2][2][4][2], const Unit& u, int wr, int wc, int fr, int fq) const {
        const int row0 = u.pm * BM + wr * 64 + fr; const int col0 = u.pn * BM + wc * 32 + 4 * fq;
#pragma unroll
        for (int bj = 0; bj < 2; ++bj)
#pragma unroll
            for (int n = 0; n < 2; ++n) { const int col = col0 + bj * HALF + n * 16; const f32x4 bv = *(const f32x4*)(gb + col);
#pragma unroll
                for (int ai = 0; ai < 2; ++ai)
#pragma unroll
                    for (int m = 0; m < 4; ++m) { const size_t row = (size_t)(row0 + ai * HALF + m * 16);
                        const u32x2 g = *(const u32x2*)(G + row * ldg + col); const f32x4 a = acc[ai][bj][m][n]; f32x4 o;
                        o[0] = sigmoidf_(__builtin_bit_cast(float, g.x << 16) + bv[0]) * a[0]; o[1] = sigmoidf_(__builtin_bit_cast(float, g.x & 0xffff0000u) + bv[1]) * a[1];
                        o[2] = sigmoidf_(__builtin_bit_cast(float, g.y << 16) + bv[2]) * a[2]; o[3] = sigmoidf_(__builtin_bit_cast(float, g.y & 0xffff0000u) + bv[3]) * a[3];
                        *(f32x4*)(T + row * 1024 + col) = o; } }
    }
};
struct EpiGate2 {
    static constexpr bool PERM = false, AFTER_DRAIN = false;
    const float* T; bf16_t* O; const bf16_t* G; int ldg; const float* gb;
    __device__ __forceinline__ void operator()(const f32x4 (&acc)[2][2][4][2], const Unit& u, int wr, int wc, int fr, int fq) const {
        const int row0 = u.pm * BM + wr * 64 + fr; const int col0 = u.pn * BM + wc * 32 + 4 * fq;
#pragma unroll
        for (int bj = 0; bj < 2; ++bj)
#pragma unroll
            for (int n = 0; n < 2; ++n) { const int col = col0 + bj * HALF + n * 16; const f32x4 bv = *(const f32x4*)(gb + col);
#pragma unroll
                for (int ai = 0; ai < 2; ++ai)
#pragma unroll
                    for (int m = 0; m < 4; ++m) { const size_t row = (size_t)(row0 + ai * HALF + m * 16);
                        const u32x2 g = *(const u32x2*)(G + row * ldg + col); const f32x4 t = *(const f32x4*)(T + row * 1024 + col); const f32x4 a = acc[ai][bj][m][n]; f32x4 o;
                        o[0] = t[0] + sigmoidf_(__builtin_bit_cast(float, g.x << 16) + bv[0]) * a[0]; o[1] = t[1] + sigmoidf_(__builtin_bit_cast(float, g.x & 0xffff0000u) + bv[1]) * a[1];
                        o[2] = t[2] + sigmoidf_(__builtin_bit_cast(float, g.y << 16) + bv[2]) * a[2]; o[3] = t[3] + sigmoidf_(__builtin_bit_cast(float, g.y & 0xffff0000u) + bv[3]) * a[3];
                        u32x2 w; w.x = cvt_pk_bf16(o[0], o[1]); w.y = cvt_pk_bf16(o[2], o[3]);
                        *(u32x2*)(O + row * 1024 + col) = w; } }
    }
};
struct EpiResid {
    static constexpr bool PERM = false, AFTER_DRAIN = false;
    const float* base; float* out; float alpha;
    __device__ __forceinline__ void operator()(const f32x4 (&acc)[2][2][4][2], const Unit& u, int wr, int wc, int fr, int fq) const {
        const int row0 = u.pm * BM + wr * 64 + fr; const int col0 = u.pn * BM + wc * 32 + 4 * fq;
#pragma unroll
        for (int ai = 0; ai < 2; ++ai)
#pragma unroll
            for (int m = 0; m < 4; ++m) { const size_t row = (size_t)(row0 + ai * HALF + m * 16);
#pragma unroll
                for (int bj = 0; bj < 2; ++bj)
#pragma unroll
                    for (int n = 0; n < 2; ++n) { const int col = col0 + bj * HALF + n * 16;
                        const f32x4 b = *(const f32x4*)(base + row * 1024 + col); const f32x4 a = acc[ai][bj][m][n];
                        *(f32x4*)(out + row * 1024 + col) = b * alpha + a; } }
    }
};

template <class Epi, class Sched, bool ALIGN_EPI = false, bool SP2 = false>
__device__ __forceinline__ void gemm_phase(PG8_LAS unsigned char* lds, const Gemm g, const Sched& S, const Epi& E) {
    const int tid = threadIdx.x, wid = __builtin_amdgcn_readfirstlane(tid >> 6), lane = tid & 63, wr = wid >> 2, wc = wid & 3, fr = lane & 15, fq = lane >> 4;
    const int K = g.K, nt = K / BK;
    unsigned voffA[2], voffB[2];
#pragma unroll
    for (int i = 0; i < 2; ++i) { int R, C; stage_rc(tid * 16 + i * 8192, R, C); const int Rb = Epi::PERM ? ((R & ~31) + perm32(R & 31)) : R;
        voffA[i] = (unsigned)(R * K + C) * 2u; voffB[i] = (unsigned)(Rb * K + C) * 2u; }
    const size_t kstep = (size_t)(BK * 2);
    const size_t hstep = (size_t)HALF * K * 2;
    const size_t tstep = 2 * hstep;
    const unsigned ldsw = (unsigned)wid * 1024u;
    const int aoff = lds_byte(wr * 64 + fr, fq * 8), boff = lds_byte(wc * 32 + fr, fq * 8);
#define PG8_SA(b, h) (((b) * 2 + (h)) * HTB)
#define PG8_SB(b, h) ((4 + (b) * 2 + (h)) * HTB)
#define PG8_STAGE(bufoff, gbase, voff) do { _Pragma("unroll") for (int _i = 0; _i < 2; ++_i) \
        __builtin_amdgcn_global_load_lds((const unsigned*)((const char*)(gbase) + (voff)[_i]), (PG8_LAS unsigned*)(lds + (bufoff) + ldsw + _i * 8192), 16, 0, 0); } while (0)
#define PG8_LDA(dst, b, h) do { _Pragma("unroll") for (int m = 0; m < 4; ++m) _Pragma("unroll") for (int k = 0; k < 2; ++k) dst[m][k] = *(const PG8_LAS bf16x8*)(lds + PG8_SA(b, h) + aoff + m * 2048 + k * 1024); } while (0)
#define PG8_LDB(dst, b, h) do { _Pragma("unroll") for (int n = 0; n < 2; ++n) _Pragma("unroll") for (int k = 0; k < 2; ++k) dst[n][k] = *(const PG8_LAS bf16x8*)(lds + PG8_SB(b, h) + boff + n * 2048 + k * 1024); } while (0)
#define PG8_MMA(ai, bj, At, Bt) do { __builtin_amdgcn_s_setprio(1); _Pragma("unroll") for (int m = 0; m < 4; ++m) _Pragma("unroll") for (int n = 0; n < 2; ++n) _Pragma("unroll") for (int k = 0; k < 2; ++k) \
        acc[ai][bj][m][n] = __builtin_amdgcn_mfma_f32_16x16x32_bf16(Bt[n][k], At[m][k], acc[ai][bj][m][n], 0, 0, 0); __builtin_amdgcn_s_setprio(0); } while (0)
#define PG8_WAIT_V(n) asm volatile("s_waitcnt vmcnt(" #n ")" ::: "memory")
#define PG8_WAIT_L(n) asm volatile("s_waitcnt lgkmcnt(" #n ")" ::: "memory")
#define PG8_BAR __builtin_amdgcn_s_barrier()
#define PG8_SCHED __builtin_amdgcn_sched_barrier(0)
    Unit cur, nxt; int ui = 0;
    if (!S.next(0, cur)) return;
    f32x4 acc[2][2][4][2];
#pragma unroll
    for (int a = 0; a < 2; ++a)
#pragma unroll
        for (int b = 0; b < 2; ++b)
#pragma unroll
            for (int m = 0; m < 4; ++m)
#pragma unroll
                for (int n = 0; n < 2; ++n) acc[a][b][m][n] = (f32x4){0.f, 0.f, 0.f, 0.f};
    bf16x8 At[4][2], B0[2][2], B1[2][2];
    const char* cA = (const char*)g.A + (size_t)cur.pm * tstep; const char* cB = (const char*)g.Bt + (size_t)cur.pn * tstep;
    S.a_ready(cur);
    if constexpr (SP2) {
        PG8_STAGE(PG8_SB(0, 0), cB, voffB); PG8_STAGE(PG8_SB(0, 1), cB + hstep, voffB); PG8_STAGE(PG8_SA(0, 0), cA, voffA); PG8_STAGE(PG8_SA(0, 1), cA + hstep, voffA);
        if (wr == 1) PG8_BAR;
        PG8_WAIT_V(2); PG8_BAR;
        PG8_STAGE(PG8_SB(1, 0), cB + kstep, voffB); PG8_STAGE(PG8_SA(1, 0), cA + kstep, voffA); PG8_STAGE(PG8_SB(1, 1), cB + hstep + kstep, voffB);
        PG8_WAIT_V(6); PG8_BAR;
    } else {
        PG8_STAGE(PG8_SB(0, 0), cB, voffB); PG8_STAGE(PG8_SA(0, 0), cA, voffA); PG8_STAGE(PG8_SB(0, 1), cB + hstep, voffB); PG8_STAGE(PG8_SA(0, 1), cA + hstep, voffA);
        if (wr == 1) PG8_BAR;
        PG8_WAIT_V(4); PG8_BAR;
        PG8_STAGE(PG8_SB(1, 0), cB + kstep, voffB); PG8_STAGE(PG8_SA(1, 0), cA + kstep, voffA); PG8_STAGE(PG8_SB(1, 1), cB + hstep + kstep, voffB);
        PG8_WAIT_V(6); PG8_BAR;
    }
    for (;;) {
        const bool has_next = S.next(ui + 1, nxt);
        const char* nA = has_next ? (const char*)g.A + (size_t)nxt.pm * tstep : cA; const char* nB = has_next ? (const char*)g.Bt + (size_t)nxt.pn * tstep : cB;
        for (int t = 0; t < nt; t += 2) {
            const bool last = (t == nt - 2);
            const char* a1 = cA + (size_t)(t + 1) * kstep;
            const char* a2 = last ? nA : cA + (size_t)(t + 2) * kstep; const char* b2 = last ? nB : cB + (size_t)(t + 2) * kstep;
            const char* a3 = a2 + kstep; const char* b3 = b2 + kstep;
            if (last && has_next) S.a_ready(nxt);
            if constexpr (SP2) {
            PG8_LDB(B0, 0, 0); PG8_LDB(B1, 0, 1); PG8_SCHED; PG8_LDA(At, 0, 0); PG8_STAGE(PG8_SA(1, 1), a1 + hstep, voffA);
            PG8_WAIT_V(8); PG8_WAIT_L(0); PG8_BAR; PG8_MMA(0, 0, At, B0); PG8_MMA(0, 1, At, B1); PG8_BAR; PG8_SCHED;
            PG8_LDA(At, 0, 1); PG8_STAGE(PG8_SB(0, 0), b2, voffB); PG8_STAGE(PG8_SB(0, 1), b2 + hstep, voffB); PG8_STAGE(PG8_SA(0, 0), a2, voffA);
            PG8_WAIT_V(8); PG8_WAIT_L(0); PG8_BAR; PG8_MMA(1, 0, At, B0); PG8_MMA(1, 1, At, B1); PG8_BAR; PG8_SCHED;
            PG8_LDB(B0, 1, 0); PG8_LDB(B1, 1, 1); PG8_SCHED; PG8_LDA(At, 1, 0); PG8_STAGE(PG8_SA(0, 1), a2 + hstep, voffA);
            PG8_WAIT_V(8); PG8_WAIT_L(0); PG8_BAR; PG8_MMA(0, 0, At, B0); PG8_MMA(0, 1, At, B1); PG8_BAR; PG8_SCHED;
            PG8_LDA(At, 1, 1); PG8_STAGE(PG8_SB(1, 0), b3, voffB); PG8_STAGE(PG8_SB(1, 1), b3 + hstep, voffB); PG8_STAGE(PG8_SA(1, 0), a3, voffA);
            PG8_WAIT_V(8); PG8_WAIT_L(0); PG8_BAR; PG8_MMA(1, 0, At, B0); PG8_MMA(1, 1, At, B1); PG8_BAR; PG8_SCHED;
            } else {
            PG8_LDB(B0, 0, 0); PG8_SCHED; PG8_LDA(At, 0, 0); PG8_STAGE(PG8_SA(1, 1), a1 + hstep, voffA);
            PG8_WAIT_L(8); PG8_BAR; PG8_WAIT_L(0); PG8_MMA(0, 0, At, B0); PG8_BAR; PG8_SCHED;
            PG8_LDB(B1, 0, 1); PG8_STAGE(PG8_SB(0, 0), b2, voffB);
            PG8_BAR; PG8_WAIT_L(0); PG8_MMA(0, 1, At, B1); PG8_BAR;
            PG8_LDA(At, 0, 1); PG8_STAGE(PG8_SA(0, 0), a2, voffA);
            PG8_BAR; PG8_WAIT_L(0); PG8_MMA(1, 0, At, B0); PG8_BAR; PG8_SCHED;
            PG8_STAGE(PG8_SB(0, 1), b2 + hstep, voffB);
            PG8_WAIT_V(6); PG8_BAR; PG8_MMA(1, 1, At, B1); PG8_BAR;
            PG8_LDB(B0, 1, 0); PG8_SCHED; PG8_LDA(At, 1, 0); PG8_STAGE(PG8_SA(0, 1), a2 + hstep, voffA);
            PG8_WAIT_L(8); PG8_BAR; PG8_WAIT_L(0); PG8_MMA(0, 0, At, B0); PG8_BAR; PG8_SCHED;
            PG8_LDB(B1, 1, 1); PG8_STAGE(PG8_SB(1, 0), b3, voffB);
            PG8_BAR; PG8_WAIT_L(0); PG8_MMA(0, 1, At, B1); PG8_BAR;
            PG8_LDA(At, 1, 1); PG8_STAGE(PG8_SA(1, 0), a3, voffA);
            PG8_BAR; PG8_WAIT_L(0); PG8_MMA(1, 0, At, B0); PG8_BAR; PG8_SCHED;
            PG8_STAGE(PG8_SB(1, 1), b3 + hstep, voffB);
            PG8_WAIT_V(6); PG8_BAR; PG8_MMA(1, 1, At, B1); PG8_BAR;
            }
        }
        if constexpr (ALIGN_EPI) { if (wr == 0) PG8_BAR; }
        if constexpr (!Epi::AFTER_DRAIN) { E(acc, cur, wr, wc, fr, fq); S.done(cur); }
        if (!has_next) break;
#pragma unroll
        for (int a = 0; a < 2; ++a)
#pragma unroll
            for (int b = 0; b < 2; ++b)
#pragma unroll
                for (int m = 0; m < 4; ++m)
#pragma unroll
                    for (int n = 0; n < 2; ++n) acc[a][b][m][n] = (f32x4){0.f, 0.f, 0.f, 0.f};
        cur = nxt; cA = nA; cB = nB; ++ui;
        if constexpr (ALIGN_EPI) { if (wr == 1) PG8_BAR; }
    }
    PG8_WAIT_V(0);
    if constexpr (!ALIGN_EPI) { if (wr == 0) PG8_BAR; }
    PG8_BAR;
    if constexpr (Epi::AFTER_DRAIN) { E.fused(acc, cur, wr, wc, fr, fq, lds, wid, lane); S.done(cur); }
#undef PG8_SA
#undef PG8_SB
#undef PG8_STAGE
#undef PG8_LDA
#undef PG8_LDB
#undef PG8_MMA
#undef PG8_WAIT_V
#undef PG8_WAIT_L
#undef PG8_BAR
#undef PG8_SCHED
}
}

#define GAS __attribute__((address_space(1)))
#define LAS __attribute__((address_space(3)))
typedef unsigned short bf16;
typedef unsigned v4u __attribute__((ext_vector_type(4)));
typedef unsigned v2u __attribute__((ext_vector_type(2)));
typedef float f32x4 __attribute__((ext_vector_type(4)));
typedef float f32x16 __attribute__((ext_vector_type(16)));
typedef short bf16x8 __attribute__((ext_vector_type(8)));
typedef short s16x4 __attribute__((ext_vector_type(4)));
typedef unsigned long long u64;

constexpr int NB = 8, SEQ = 4096, M = NB * SEQ, DM = 1024, DC = 512, DA = 512, NH = 8, HD = 64, FF = 4096;
constexpr int NIN = 5192, NPROJ = 5376;
constexpr int PC_A = 0, PC_B = 512, PC_Q = 1024, PC_K = 1536, PC_V = 2048, PC_QI = 2560, PC_GC = 3072, PC_GA = 4096, PC_KI = 5120, PC_WI = 5184;
constexpr float LN_EPS = 1e-5f;
constexpr float DN_ALPHA = 1.189207115002721f;
constexpr float C2 = 0.125f * 1.4426950408889634f;
constexpr int NWAVES = 8, NTHREADS = 512;
constexpr int LDS_BYTES = 147456;

constexpr size_t MiB = 1u << 20;
constexpr size_t WS_CTL = 0;
constexpr size_t WS_WIN = 1 * MiB, WS_WCO = 12 * MiB, WS_WAO = 13 * MiB, WS_WO = 14 * MiB, WS_WF1 = 16 * MiB, WS_WF2 = 24 * MiB;
constexpr size_t WS_PROJ = 32 * MiB;
constexpr size_t WS_XB = 368 * MiB;
constexpr size_t WS_CU = 432 * MiB;
constexpr size_t WS_AT = 464 * MiB;
constexpr size_t WS_X1 = 32 * MiB;
constexpr size_t WS_X1B = 160 * MiB;
constexpr size_t WS_H = 224 * MiB;
constexpr size_t WS_END = 512 * MiB;
constexpr size_t DO_BM = 0, DO_KIR = 16 * MiB, DO_WIS = 20 * MiB;

__device__ __forceinline__ unsigned f2bf(float f) { unsigned u = __builtin_bit_cast(unsigned, f); return (u + 0x7fffu + ((u >> 16) & 1u)) >> 16; }
__device__ __forceinline__ unsigned pk2(float lo, float hi) { return f2bf(lo) | (f2bf(hi) << 16); }
__device__ __forceinline__ float bflo(unsigned w) { return __builtin_bit_cast(float, w << 16); }
__device__ __forceinline__ float bfhi(unsigned w) { return __builtin_bit_cast(float, w & 0xffff0000u); }
__device__ __forceinline__ float bf2f(bf16 b) { return __builtin_bit_cast(float, (unsigned)b << 16); }
__device__ __forceinline__ float wave_sum(float v) {
#pragma unroll
    for (int o = 1; o < 64; o <<= 1) v += __shfl_xor(v, o);
    return v;
}
__device__ __forceinline__ float sigm(float v) { return __builtin_amdgcn_rcpf(1.0f + __builtin_amdgcn_exp2f(-1.4426950408889634f * v)); }
__device__ __forceinline__ int crow(int r, int hi) { return (r & 3) + 8 * (r >> 2) + 4 * hi; }
#define LDS_WAIT() asm volatile("s_waitcnt lgkmcnt(0)" ::: "memory")

struct Params {
    const float* x; const float* w_in; const float* dw_w; const float* dw_b; const float* cln_g; const float* cln_b; const float* w_co;
    const float* kln_g; const float* kln_b; const float* w_ao; const float* gate_b; const float* w_o; const float* ln1_g; const float* ln1_b;
    const float* w_f1; const float* w_f2; const float* ln2_g; const float* ln2_b;
    float* out; unsigned char* ws;
};

__device__ __forceinline__ int win_src_col(int n) { return n < 3072 ? n : (n < 5120 ? n + 72 : (n < 5192 ? n - 2048 : -1)); }
template <bool MAPWIN>
__device__ __forceinline__ void transpose_item(const float* W, int K, int Nsrc, int Nnew, bf16* WT, LAS float* scr, int item, int lane) {
    const int nblk = Nnew / 32, kb = item / nblk, nb = item % nblk, k0 = 64 * kb, n0 = 32 * nb;
    const int nn = n0 + (lane & 31); const int sc = MAPWIN ? win_src_col(nn) : nn;
#pragma unroll 8
    for (int i = 0; i < 32; ++i) { const int kk = 2 * i + (lane >> 5); scr[kk * 33 + (lane & 31)] = sc >= 0 ? W[(size_t)(k0 + kk) * Nsrc + sc] : 0.f; }
    LDS_WAIT(); asm volatile("" ::: "memory");
    const int c = lane & 7;
#pragma unroll
    for (int j = 0; j < 4; ++j) { const int n = (lane >> 3) + 8 * j; const LAS float* s = scr + (8 * c) * 33 + n;
        v4u o; o.x = pk2(s[0 * 33], s[1 * 33]); o.y = pk2(s[2 * 33], s[3 * 33]); o.z = pk2(s[4 * 33], s[5 * 33]); o.w = pk2(s[6 * 33], s[7 * 33]);
        *(v4u*)(WT + (size_t)(n0 + n) * K + k0 + 8 * c) = o; }
    LDS_WAIT(); asm volatile("" ::: "memory");
}
__device__ __forceinline__ void phase0(const Params& p, LAS unsigned char* lds, int gw, int NGW, int wave, int lane) {
    LAS float* scr = (LAS float*)(lds + wave * 16384);
    bf16* WinT = (bf16*)(p.ws + WS_WIN); bf16* WcoT = (bf16*)(p.ws + WS_WCO); bf16* WaoT = (bf16*)(p.ws + WS_WAO); bf16* WoT = (bf16*)(p.ws + WS_WO);
    bf16* Wf1T = (bf16*)(p.ws + WS_WF1); bf16* Wf2T = (bf16*)(p.ws + WS_WF2);
    constexpr int I_IN = (DM / 64) * (NPROJ / 32), I_CO = (DC / 64) * (DM / 32), I_AO = I_CO, I_O = (DM / 64) * (DM / 32), I_F1 = (DM / 64) * (FF / 32), I_F2 = (FF / 64) * (DM / 32);
    constexpr int NITEMS = I_IN + I_CO + I_AO + I_O + I_F1 + I_F2;
    for (int it = gw; it < NITEMS; it += NGW) {
        int r = it;
        if (r < I_IN) { transpose_item<true>(p.w_in, DM, NIN, NPROJ, WinT, scr, r, lane); continue; } r -= I_IN;
        if (r < I_CO) { transpose_item<false>(p.w_co, DC, DM, DM, WcoT, scr, r, lane); continue; } r -= I_CO;
        if (r < I_AO) { transpose_item<false>(p.w_ao, DA, DM, DM, WaoT, scr, r, lane); continue; } r -= I_AO;
        if (r < I_O) { transpose_item<false>(p.w_o, DM, DM, DM, WoT, scr, r, lane); continue; } r -= I_O;
        if (r < I_F1) { transpose_item<false>(p.w_f1, DM, FF, FF, Wf1T, scr, r, lane); continue; } r -= I_F1;
        transpose_item<false>(p.w_f2, FF, DM, DM, Wf2T, scr, r, lane);
    }
    bf16* xb = (bf16*)(p.ws + WS_XB);
    for (int m = gw; m < M; m += NGW) {
        const f32x4* xr = (const f32x4*)(p.x + (size_t)m * DM) + lane; u64* o8 = (u64*)(xb + (size_t)m * DM) + lane;
#pragma unroll
        for (int j = 0; j < 4; ++j) { const f32x4 v = xr[64 * j]; o8[64 * j] = (u64)pk2(v[0], v[1]) | ((u64)pk2(v[2], v[3]) << 32); }
    }
}

__device__ __forceinline__ void rope8(v4u& w, const float* cs, const float* sn, bool second, float scale) {
    v4u pw; pw.x = __shfl_xor(w.x, 4); pw.y = __shfl_xor(w.y, 4); pw.z = __shfl_xor(w.z, 4); pw.w = __shfl_xor(w.w, 4);
    float own[8] = {bflo(w.x), bfhi(w.x), bflo(w.y), bfhi(w.y), bflo(w.z), bfhi(w.z), bflo(w.w), bfhi(w.w)};
    float oth[8] = {bflo(pw.x), bfhi(pw.x), bflo(pw.y), bfhi(pw.y), bflo(pw.z), bfhi(pw.z), bflo(pw.w), bfhi(pw.w)};
    float o[8];
#pragma unroll
    for (int i = 0; i < 8; ++i) o[i] = (second ? (own[i] * cs[i] + oth[i] * sn[i]) : (own[i] * cs[i] - oth[i] * sn[i])) * scale;
    w.x = pk2(o[0], o[1]); w.y = pk2(o[2], o[3]); w.z = pk2(o[4], o[5]); w.w = pk2(o[6], o[7]);
}
__device__ __forceinline__ void sincos_rev(float ang, float& s, float& c) {
    double t = (double)ang * 0.15915494309189535; t -= __builtin_rint(t); const float rev = (float)t;
    s = __builtin_amdgcn_sinf(rev); c = __builtin_amdgcn_cosf(rev);
}
__device__ __forceinline__ void phase2a(const Params& p, int gw, int NGW, int lane) {
    bf16* proj = (bf16*)(p.ws + WS_PROJ);
    bf16* kir = (bf16*)((unsigned char*)p.out + DO_KIR); float* wis = (float*)((unsigned char*)p.out + DO_WIS);
    float invf[8];
#pragma unroll
    for (int i = 0; i < 8; ++i) invf[i] = (float)::exp2(-(double)((lane & 3) * 8 + i) * (13.287712379549449 / 32.0));
    const float invf1 = (float)::exp2(-(double)(lane & 31) * (13.287712379549449 / 32.0));
    const float kg = p.kln_g[lane], kb = p.kln_b[lane];
    const bool second = (lane & 7) >= 4;
    for (int tok = gw; tok < M; tok += NGW) {
        bf16* row = proj + (size_t)tok * NPROJ; const float pos = (float)(tok & (SEQ - 1));
        float cs[8], sn[8];
#pragma unroll
        for (int i = 0; i < 8; ++i) sincos_rev(pos * invf[i], sn[i], cs[i]);
        v4u q = *(const v4u*)(row + PC_Q + lane * 8), k = *(const v4u*)(row + PC_K + lane * 8), qi = *(const v4u*)(row + PC_QI + lane * 8);
        const float kiv = bf2f(row[PC_KI + lane]);
        const float wv = lane < 8 ? bf2f(row[PC_WI + lane]) : 0.f;
        rope8(q, cs, sn, second, C2); rope8(k, cs, sn, second, 1.f); rope8(qi, cs, sn, second, 1.f);
        *(v4u*)(row + PC_Q + lane * 8) = q; *(v4u*)(row + PC_K + lane * 8) = k; *(v4u*)(row + PC_QI + lane * 8) = qi;
        const float mean = wave_sum(kiv) * (1.f / 64.f); const float d = kiv - mean; const float var = wave_sum(d * d) * (1.f / 64.f);
        const float y = d * (1.0f / sqrtf(var + LN_EPS)) * kg + kb;
        float s1, c1; sincos_rev(pos * invf1, s1, c1);
        const float oth = __shfl_xor(y, 32);
        const float yo = lane < 32 ? (y * c1 - oth * s1) : (y * c1 + oth * s1);
        kir[(size_t)tok * 64 + lane] = (bf16)f2bf(yo);
        if (lane < 8) wis[(size_t)tok * 8 + lane] = wv * 0.04419417382415922f;
    }
}

__device__ __forceinline__ void phase2b(const Params& p, LAS unsigned char* lds, int bid, int nblk, int tid, int wave, int lane) {
    const bf16* proj = (const bf16*)(p.ws + WS_PROJ); bf16* cu = (bf16*)(p.ws + WS_CU);
    LAS float* U = (LAS float*)lds;
    float w[31];
#pragma unroll
    for (int j = 0; j < 31; ++j) w[j] = p.dw_w[j * DC + tid];
    const float bias = p.dw_b[tid];
    constexpr int TT = 32, NTILE = M / TT;
    for (int tile = bid; tile < NTILE; tile += nblk) {
        const int tok0 = tile * TT; const int t0 = tok0 & (SEQ - 1);
        __syncthreads();
        for (int r = (tid >> 6); r < 62; r += 8) {
            const int c8 = (tid & 63) * 8; f32x4 u0 = {0.f, 0.f, 0.f, 0.f}, u1 = {0.f, 0.f, 0.f, 0.f};
            if (t0 - 30 + r >= 0) {
                const bf16* row = proj + (size_t)(tok0 - 30 + r) * NPROJ;
                const v4u a = *(const v4u*)(row + PC_A + c8), b = *(const v4u*)(row + PC_B + c8);
                u0[0] = bflo(a.x) * sigm(bflo(b.x)); u0[1] = bfhi(a.x) * sigm(bfhi(b.x)); u0[2] = bflo(a.y) * sigm(bflo(b.y)); u0[3] = bfhi(a.y) * sigm(bfhi(b.y));
                u1[0] = bflo(a.z) * sigm(bflo(b.z)); u1[1] = bfhi(a.z) * sigm(bfhi(b.z)); u1[2] = bflo(a.w) * sigm(bflo(b.w)); u1[3] = bfhi(a.w) * sigm(bfhi(b.w));
            }
            *(LAS f32x4*)(U + r * DC + c8) = u0; *(LAS f32x4*)(U + r * DC + c8 + 4) = u1;
        }
        __syncthreads();
        float o[TT];
#pragma unroll
        for (int t = 0; t < TT; ++t) o[t] = bias;
#pragma unroll
        for (int r = 0; r < 62; ++r) { const float v = U[r * DC + tid];
#pragma unroll
            for (int t = 0; t < TT; ++t) { if (r - t >= 0 && r - t <= 30) o[t] += w[r - t] * v; } }
#pragma unroll
        for (int t = 0; t < TT; ++t) U[t * DC + tid] = o[t];
        __syncthreads();
#pragma unroll
        for (int i = 0; i < 4; ++i) { const int t = wave * 4 + i;
            const f32x4 a = *(const LAS f32x4*)(U + t * DC + lane * 8), b = *(const LAS f32x4*)(U + t * DC + lane * 8 + 4);
            const float mean = wave_sum((a[0] + a[1]) + (a[2] + a[3]) + (b[0] + b[1]) + (b[2] + b[3])) * (1.f / DC);
            const f32x4 da = a - mean, db = b - mean;
            const float var = wave_sum((da[0] * da[0] + da[1] * da[1]) + (da[2] * da[2] + da[3] * da[3]) + (db[0] * db[0] + db[1] * db[1]) + (db[2] * db[2] + db[3] * db[3])) * (1.f / DC);
            const float rstd = 1.0f / sqrtf(var + LN_EPS);
            const f32x4 g0 = *(const f32x4*)(p.cln_g + lane * 8), g1 = *(const f32x4*)(p.cln_g + lane * 8 + 4), b0 = *(const f32x4*)(p.cln_b + lane * 8), b1 = *(const f32x4*)(p.cln_b + lane * 8 + 4);
            float y[8];
#pragma unroll
            for (int e = 0; e < 4; ++e) { y[e] = da[e] * rstd * g0[e] + b0[e]; y[4 + e] = db[e] * rstd * g1[e] + b1[e]; }
#pragma unroll
            for (int e = 0; e < 8; ++e) y[e] = y[e] * sigm(y[e]);
            v4u ov; ov.x = pk2(y[0], y[1]); ov.y = pk2(y[2], y[3]); ov.z = pk2(y[4], y[5]); ov.w = pk2(y[6], y[7]);
            *(v4u*)(cu + (size_t)(tok0 + t) * DC + lane * 8) = ov; }
    }
}

__device__ __forceinline__ unsigned mono(float f) { const unsigned b = __builtin_bit_cast(unsigned, f); return (b & 0x80000000u) ? ~b : (b | 0x80000000u); }
template <int NVMAX>
__device__ __forceinline__ u64 select_row(const LAS float* sc, int S, int lane) {
    unsigned u[NVMAX];
#pragma unroll
    for (int j = 0; j < NVMAX; ++j) u[j] = (j * 64 < S) ? mono(sc[j * 64 + lane]) : 0u;
    unsigned T = 0u; bool exact = false;
    for (int bit = 31; bit >= 0; --bit) {
        const unsigned cand = T | (1u << bit); int cnt = 0;
#pragma unroll
        for (int j = 0; j < NVMAX; ++j) cnt += __popcll(__ballot(u[j] >= cand));
        if (cnt >= 256) { T = cand; if (cnt == 256) { exact = true; break; } }
    }
    u64 mine = 0ull;
    bool ties = false;
    if (!exact) { int cge = 0;
#pragma unroll
        for (int j = 0; j < NVMAX; ++j) cge += __popcll(__ballot(u[j] >= T));
        ties = cge > 256; }
    if (!ties) {
#pragma unroll
        for (int j = 0; j < NVMAX; ++j) { const u64 mk = __ballot(u[j] >= T); if (lane == j) mine = mk; }
    } else {
        int cgt = 0;
#pragma unroll
        for (int j = 0; j < NVMAX; ++j) cgt += __popcll(__ballot(u[j] > T));
        int need = 256 - cgt;
#pragma unroll
        for (int j = 0; j < NVMAX; ++j) { const u64 gt = __ballot(u[j] > T); u64 eq = __ballot(u[j] == T);
            int k = __popcll(eq);
            if (k > need) { u64 kept = 0ull; for (int i = 0; i < need; ++i) { const u64 low = eq & (0ull - eq); kept |= low; eq ^= low; } eq = kept; k = need; }
            need -= k; const u64 mk = gt | eq; if (lane == j) mine = mk; }
    }
    return mine;
}
__device__ __forceinline__ void idx_tile(const Params& p, LAS unsigned char* lds, int b, int c, int sub, int tid, int wave, int lane) {
    const bf16* proj = (const bf16*)(p.ws + WS_PROJ);
    const bf16* kir = (const bf16*)((const unsigned char*)p.out + DO_KIR); const float* wis = (const float*)((const unsigned char*)p.out + DO_WIS);
    u64* bm = (u64*)((unsigned char*)p.out + DO_BM);
    const int S = 64 * (c + 1); const size_t rowbase = (size_t)b * SEQ; const size_t q0 = rowbase + c * 64 + sub * 8;
    if (c < 4) {
        u64* o = bm + (q0 + wave) * 64; o[lane] = (lane < c + 1) ? ~0ull : 0ull; return;
    }
    LAS float* SC = (LAS float*)lds;
    const int r = lane & 31, h = lane >> 5;
    {
        const int hh = (r >> 2) & 1, reg = (r & 3) + 4 * (r >> 3), ql = (reg >> 3) + 2 * hh, head = reg & 7;
        bf16x8 af[2][4]; float wv[2][2][8];
#pragma unroll
        for (int rb = 0; rb < 2; ++rb) { const bf16* src = proj + (q0 + rb * 4 + ql) * NPROJ + PC_QI + head * 64 + 32 * h;
#pragma unroll
            for (int s = 0; s < 4; ++s) af[rb][s] = *(const bf16x8*)(src + 8 * s);
#pragma unroll
            for (int e = 0; e < 2; ++e) { const float* wsrc = wis + (q0 + rb * 4 + 2 * h + e) * 8; const f32x4 w0 = *(const f32x4*)wsrc, w1 = *(const f32x4*)(wsrc + 4);
#pragma unroll
                for (int i = 0; i < 4; ++i) { wv[rb][e][i] = w0[i]; wv[rb][e][4 + i] = w1[i]; } } }
        const int nct = S / 32;
        for (int ct = wave; ct < nct; ct += 8) {
            const bf16* ksrc = kir + (rowbase + ct * 32 + r) * 64 + 32 * h;
            bf16x8 bfr[4];
#pragma unroll
            for (int s = 0; s < 4; ++s) bfr[s] = *(const bf16x8*)(ksrc + 8 * s);
#pragma unroll
            for (int rb = 0; rb < 2; ++rb) { f32x16 acc;
#pragma unroll
                for (int i = 0; i < 16; ++i) acc[i] = 0.f;
#pragma unroll
                for (int s = 0; s < 4; ++s) acc = __builtin_amdgcn_mfma_f32_32x32x16_bf16(af[rb][s], bfr[s], acc, 0, 0, 0);
#pragma unroll
                for (int e = 0; e < 2; ++e) { float sum = 0.f;
#pragma unroll
                    for (int i = 0; i < 8; ++i) sum += wv[rb][e][i] * __builtin_fmaxf(acc[8 * e + i], 0.f);
                    SC[(rb * 4 + 2 * h + e) * 4096 + ct * 32 + r] = sum; } }
        }
    }
    __syncthreads();
    {
        const LAS float* sc = SC + wave * 4096; u64 mine;
        if (S <= 1024) mine = select_row<16>(sc, S, lane);
        else if (S <= 2048) mine = select_row<32>(sc, S, lane);
        else if (S <= 3072) mine = select_row<48>(sc, S, lane);
        else mine = select_row<64>(sc, S, lane);
        bm[(q0 + wave) * 64 + lane] = mine;
    }
    __syncthreads();
}
__device__ __forceinline__ void phase3(const Params& p, LAS unsigned char* lds, int bid, int nblk, int tid, int wave, int lane) {
    for (int pr = bid; pr < 2048; pr += nblk) {
        const int cp = pr & 31, sub = (pr >> 5) & 7, b = pr >> 8;
        idx_tile(p, lds, b, cp, sub, tid, wave, lane);
        idx_tile(p, lds, b, 63 - cp, sub, tid, wave, lane);
    }
}

__device__ __forceinline__ s16x4 vtr(const LAS unsigned char* p) { typedef short v4i16_t __attribute__((ext_vector_type(4))); return __builtin_bit_cast(s16x4, __builtin_amdgcn_ds_read_tr16_b64_v4i16((LAS v4i16_t*)p)); }
__device__ __forceinline__ unsigned cvtpk(float lo, float hi) { unsigned r; asm volatile("v_cvt_pk_bf16_f32 %0, %1, %2" : "=v"(r) : "v"(lo), "v"(hi)); return r; }
__device__ __forceinline__ void attn_unit(const Params& p, LAS unsigned char* lds, int b, int h, int qb, int tid, int wid, int lane) {
    const bf16* proj = (const bf16*)(p.ws + WS_PROJ); const u64* bm = (const u64*)((const unsigned char*)p.out + DO_BM); bf16* attn = (bf16*)(p.ws + WS_AT);
    const int r32 = lane & 31, hi = lane >> 5;
    const size_t rowbase = (size_t)b * SEQ; const int q0 = qb * 256;
    LAS unsigned char* Kl = lds; LAS unsigned char* Vl = lds + 8192; LAS float* wsf = (LAS float*)(lds + 16384) + wid * 64; LAS bf16* stg = (LAS bf16*)(lds + 16384 + 2048) + wid * 2048;
    const bf16* Qw = proj + (rowbase + q0 + wid * 32) * NPROJ + PC_Q + h * 64;
    bf16x8 qr[4];
#pragma unroll
    for (int d0 = 0; d0 < 4; ++d0) qr[d0] = *(const bf16x8*)(Qw + (size_t)r32 * NPROJ + d0 * 16 + hi * 8);
    const int NT = 4 * (qb + 1);
    const bf16* ksrc = proj + (rowbase + lane) * NPROJ + PC_K + h * 64 + wid * 8;
    const bf16* vsrc = proj + (rowbase + 16 * (wid & 3) + (lane >> 2)) * NPROJ + PC_V + h * 64 + (wid >> 2) * 32 + (lane & 3) * 8;
    const u64* bmq = bm + (rowbase + q0 + wid * 32 + r32) * 64;
    const LAS unsigned char* vb = Vl + ((lane >> 4) & 1) * 32 + (lane & 3) * 8 + (4 * hi + ((lane & 15) >> 2)) * 64;
    float m = -1e30f, l = 0.f; f32x16 o0, o1;
#pragma unroll
    for (int i = 0; i < 16; ++i) { o0[i] = 0.f; o1[i] = 0.f; }
    v4u kreg = *(const v4u*)ksrc, vreg = *(const v4u*)vsrc, mw4 = {0u, 0u, 0u, 0u};
    for (int t = 0; t < NT; ++t) {
        __syncthreads();
        *(LAS v4u*)(Kl + wid * 1024 + lane * 16) = kreg; *(LAS v4u*)(Vl + wid * 1024 + lane * 16) = vreg;
        __syncthreads();
        if (t + 1 < NT) { kreg = *(const v4u*)(ksrc + (size_t)(t + 1) * 64 * NPROJ); vreg = *(const v4u*)(vsrc + (size_t)(t + 1) * 64 * NPROJ); }
        if ((t & 1) == 0) mw4 = *(const v4u*)(bmq + t);
        unsigned lo = (t & 1) ? mw4.z : mw4.x, hw = (t & 1) ? mw4.w : mw4.y;
        lo >>= 4 * hi; hw >>= 4 * hi;
        f32x16 c0, c1;
#pragma unroll
        for (int r = 0; r < 16; ++r) { const int bp = (r & 3) + 8 * (r >> 2); c0[r] = ((lo >> bp) & 1u) ? 0.f : -1e30f; c1[r] = ((hw >> bp) & 1u) ? 0.f : -1e30f; }
#pragma unroll
        for (int d0 = 0; d0 < 4; ++d0) {
            const bf16x8 k0 = *(const LAS bf16x8*)(Kl + (2 * d0 + hi) * 1024 + r32 * 16), k1 = *(const LAS bf16x8*)(Kl + (2 * d0 + hi) * 1024 + r32 * 16 + 512);
            c0 = __builtin_amdgcn_mfma_f32_32x32x16_bf16(k0, qr[d0], c0, 0, 0, 0); c1 = __builtin_amdgcn_mfma_f32_32x32x16_bf16(k1, qr[d0], c1, 0, 0, 0);
        }
        float rm = __builtin_fmaxf(c0[0], c1[0]);
#pragma unroll
        for (int r = 1; r < 16; ++r) rm = __builtin_fmaxf(rm, __builtin_fmaxf(c0[r], c1[r]));
        rm = __builtin_fmaxf(rm, __shfl_xor(rm, 32));
        const float mn = __builtin_fmaxf(m, rm); const float alpha = __builtin_amdgcn_exp2f(m - mn);
        m = mn; l *= alpha;
        if (__any(alpha != 1.0f)) {
            if (hi == 0) wsf[r32] = alpha;
#pragma unroll
            for (int r = 0; r < 16; ++r) { const float f = wsf[crow(r, hi)]; o0[r] *= f; o1[r] *= f; }
        }
        float ps = 0.f;
#pragma unroll
        for (int r = 0; r < 16; ++r) { c0[r] = __builtin_amdgcn_exp2f(c0[r] - mn); c1[r] = __builtin_amdgcn_exp2f(c1[r] - mn); ps += c0[r] + c1[r]; }
        l += ps;
        v4u pw[4];
#pragma unroll
        for (int ks = 0; ks < 2; ++ks) {
            pw[ks] = (v4u){cvtpk(c0[8 * ks + 0], c0[8 * ks + 1]), cvtpk(c0[8 * ks + 2], c0[8 * ks + 3]), cvtpk(c0[8 * ks + 4], c0[8 * ks + 5]), cvtpk(c0[8 * ks + 6], c0[8 * ks + 7])};
            pw[2 + ks] = (v4u){cvtpk(c1[8 * ks + 0], c1[8 * ks + 1]), cvtpk(c1[8 * ks + 2], c1[8 * ks + 3]), cvtpk(c1[8 * ks + 4], c1[8 * ks + 5]), cvtpk(c1[8 * ks + 6], c1[8 * ks + 7])};
        }
#pragma unroll
        for (int ks = 0; ks < 4; ++ks) {
            const s16x4 a0 = vtr(vb + ks * 1024), a1 = vtr(vb + ks * 1024 + 512), b0 = vtr(vb + 4096 + ks * 1024), b1 = vtr(vb + 4096 + ks * 1024 + 512);
            const bf16x8 v0 = (bf16x8){a0[0], a0[1], a0[2], a0[3], a1[0], a1[1], a1[2], a1[3]}, v1 = (bf16x8){b0[0], b0[1], b0[2], b0[3], b1[0], b1[1], b1[2], b1[3]};
            const bf16x8 pa = __builtin_bit_cast(bf16x8, pw[ks]);
            o0 = __builtin_amdgcn_mfma_f32_32x32x16_bf16(pa, v0, o0, 0, 0, 0); o1 = __builtin_amdgcn_mfma_f32_32x32x16_bf16(pa, v1, o1, 0, 0, 0);
        }
    }
    l += __shfl_xor(l, 32);
    if (hi == 0) wsf[32 + r32] = l;
#pragma unroll
    for (int r = 0; r < 16; ++r) { const float rl = __builtin_amdgcn_rcpf(wsf[32 + crow(r, hi)]); const int orow = crow(r, hi);
        stg[orow * 64 + r32] = (bf16)f2bf(o0[r] * rl); stg[orow * 64 + 32 + r32] = (bf16)f2bf(o1[r] * rl); }
    bf16* Ow = attn + (rowbase + q0 + wid * 32) * DA + h * 64;
#pragma unroll
    for (int i = 0; i < 4; ++i) { const int row = i * 8 + (lane >> 3), ch = lane & 7; const v4u v = *(const LAS v4u*)(stg + row * 64 + ch * 8); *(v4u*)(Ow + (size_t)row * DA + ch * 8) = v; }
}
__device__ __forceinline__ void phase4(const Params& p, LAS unsigned char* lds, int vcu, int tid, int wid, int lane) {
    for (int v = vcu; v < 256; v += gridDim.x) {
        const int bh = v >> 2, s = v & 3;
#pragma unroll 1
        for (int i = 0; i < 4; ++i) { const int qb = (i == 0) ? s : (i == 1) ? 7 - s : (i == 2) ? 8 + s : 15 - s; attn_unit(p, lds, bh >> 3, bh & 7, qb, tid, wid, lane); }
    }
}

template <bool WB> __device__ __forceinline__ void ln_rows(const float* src, float* dst, bf16* dstb, const float* g, const float* bta, int gw, int NGW, int lane) {
    f32x4 gv[4], bv[4];
#pragma unroll
    for (int j = 0; j < 4; ++j) { gv[j] = ((const f32x4*)g)[lane + 64 * j]; bv[j] = ((const f32x4*)bta)[lane + 64 * j]; }
    for (int m = gw; m < M; m += NGW) {
        const f32x4* xr = (const f32x4*)(src + (size_t)m * DM) + lane; f32x4 v[4]; float s = 0.f;
#pragma unroll
        for (int j = 0; j < 4; ++j) { v[j] = xr[64 * j]; s += (v[j][0] + v[j][1]) + (v[j][2] + v[j][3]); }
        const float mean = wave_sum(s) * (1.f / DM); float s2 = 0.f;
#pragma unroll
        for (int j = 0; j < 4; ++j) { v[j] = v[j] - mean; s2 += (v[j][0] * v[j][0] + v[j][1] * v[j][1]) + (v[j][2] * v[j][2] + v[j][3] * v[j][3]); }
        const float rstd = 1.f / sqrtf(wave_sum(s2) * (1.f / DM) + LN_EPS);
        f32x4* orow = (f32x4*)(dst + (size_t)m * DM) + lane;
#pragma unroll
        for (int j = 0; j < 4; ++j) { const f32x4 y = v[j] * rstd * gv[j] + bv[j]; orow[64 * j] = y;
            if (WB) ((u64*)(dstb + (size_t)m * DM))[lane + 64 * j] = (u64)pk2(y[0], y[1]) | ((u64)pk2(y[2], y[3]) << 32); }
    }
}

__global__ void __launch_bounds__(NTHREADS, 2) fwd_kernel(Params p) {
    extern __shared__ __attribute__((aligned(16))) unsigned char lds_raw[];
    cg::grid_group grid = cg::this_grid();
    LAS unsigned char* lds = (LAS unsigned char*)lds_raw;
    const int tid = threadIdx.x, lane = tid & 63, wave = __builtin_amdgcn_readfirstlane(tid >> 6);
    const int G = gridDim.x, bid = blockIdx.x;
    const int vcu = (G % 8 == 0) ? (bid % 8) * (G / 8) + bid / 8 : bid;
    const int gw = vcu * NWAVES + wave, NGW = G * NWAVES;
    unsigned char* ws = p.ws;
    bf16* proj = (bf16*)(ws + WS_PROJ);

    phase0(p, lds, gw, NGW, wave, lane);
    grid.sync();
    {
        pg8::Gemm g{(const bf16*)(ws + WS_XB), (const bf16*)(ws + WS_WIN), M, NPROJ, DM}; pg8::StaticOrder S; S.init(M, NPROJ, G, bid);
        pg8::EpiBf16<0> E{proj, NPROJ};
        pg8::gemm_phase<pg8::EpiBf16<0>, pg8::StaticOrder, true, true>(lds, g, S, E);
    }
    grid.sync();
    phase2a(p, gw, NGW, lane);
    phase2b(p, lds, vcu, G, tid, wave, lane);
    grid.sync();
    phase3(p, lds, vcu, G, tid, wave, lane);
    grid.sync();
    phase4(p, lds, vcu, tid, wave, lane);
    grid.sync();
    {
        pg8::Gemm g{(const bf16*)(ws + WS_CU), (const bf16*)(ws + WS_WCO), M, DM, DC}; pg8::StaticOrder S; S.init(M, DM, G, bid);
        pg8::EpiGate1 E{p.out, proj + PC_GC, NPROJ, p.gate_b};
        pg8::gemm_phase<pg8::EpiGate1, pg8::StaticOrder, true, true>(lds, g, S, E);
    }
    __syncthreads();
    {
        pg8::Gemm g{(const bf16*)(ws + WS_AT), (const bf16*)(ws + WS_WAO), M, DM, DA}; pg8::StaticOrder S; S.init(M, DM, G, bid);
        pg8::EpiGate2 E{p.out, (bf16*)(ws + WS_XB), proj + PC_GA, NPROJ, p.gate_b + DM};
        pg8::gemm_phase<pg8::EpiGate2, pg8::StaticOrder, true, true>(lds, g, S, E);
    }
    grid.sync();
    {
        pg8::Gemm g{(const bf16*)(ws + WS_XB), (const bf16*)(ws + WS_WO), M, DM, DM}; pg8::StaticOrder S; S.init(M, DM, G, bid);
        pg8::EpiResid E{p.x, p.out, DN_ALPHA};
        pg8::gemm_phase<pg8::EpiResid, pg8::StaticOrder, true, true>(lds, g, S, E);
    }
    grid.sync();
    ln_rows<true>(p.out, (float*)(ws + WS_X1), (bf16*)(ws + WS_X1B), p.ln1_g, p.ln1_b, gw, NGW, lane);
    grid.sync();
    {
        pg8::Gemm g{(const bf16*)(ws + WS_X1B), (const bf16*)(ws + WS_WF1), M, FF, DM}; pg8::StaticOrder S; S.init(M, FF, G, bid);
        pg8::EpiBf16<2> E{(bf16*)(ws + WS_H), FF};
        pg8::gemm_phase<pg8::EpiBf16<2>, pg8::StaticOrder, true, true>(lds, g, S, E);
    }
    grid.sync();
    {
        pg8::Gemm g{(const bf16*)(ws + WS_H), (const bf16*)(ws + WS_WF2), M, DM, FF}; pg8::StaticOrder S; S.init(M, DM, G, bid);
        pg8::EpiResid E{(const float*)(ws + WS_X1), p.out, DN_ALPHA};
        pg8::gemm_phase<pg8::EpiResid, pg8::StaticOrder, true, true>(lds, g, S, E);
    }
    grid.sync();
    ln_rows<false>(p.out, p.out, nullptr, p.ln2_g, p.ln2_b, gw, NGW, lane);
}

extern "C" void kernel_launch(void* const* d_in, const int* in_sizes, int n_in, void* d_out, int out_size, void* d_ws, size_t ws_size, hipStream_t stream) {
    static int grid = 0;
    if (grid == 0) {
        if (n_in != 18 || in_sizes[0] != M * DM || out_size != M * DM || ws_size < WS_END) { fprintf(stderr, "kernel_launch: unexpected shapes (n_in %d, in0 %d, out %d, ws %zu)\n", n_in, n_in > 0 ? in_sizes[0] : -1, out_size, ws_size); grid = -1; return; }
        int dev = 0, cus = 0, per_cu = 0;
        if (hipGetDevice(&dev) != hipSuccess || hipDeviceGetAttribute(&cus, hipDeviceAttributeMultiprocessorCount, dev) != hipSuccess) { grid = -1; return; }
        if (hipFuncSetAttribute((const void*)fwd_kernel, hipFuncAttributeMaxDynamicSharedMemorySize, LDS_BYTES) != hipSuccess) { fprintf(stderr, "kernel_launch: hipFuncSetAttribute failed\n"); grid = -1; return; }
        if (hipOccupancyMaxActiveBlocksPerMultiprocessor(&per_cu, (const void*)fwd_kernel, NTHREADS, LDS_BYTES) != hipSuccess || per_cu < 1) { fprintf(stderr, "kernel_launch: occupancy query says %d\n", per_cu); (void)hipGetLastError(); per_cu = 1; }
        grid = cus;
    }
    if (grid < 0) return;
    Params p{};
    p.x = (const float*)d_in[0]; p.w_in = (const float*)d_in[1]; p.dw_w = (const float*)d_in[2]; p.dw_b = (const float*)d_in[3]; p.cln_g = (const float*)d_in[4]; p.cln_b = (const float*)d_in[5];
    p.w_co = (const float*)d_in[6]; p.kln_g = (const float*)d_in[7]; p.kln_b = (const float*)d_in[8]; p.w_ao = (const float*)d_in[9]; p.gate_b = (const float*)d_in[10]; p.w_o = (const float*)d_in[11];
    p.ln1_g = (const float*)d_in[12]; p.ln1_b = (const float*)d_in[13]; p.w_f1 = (const float*)d_in[14]; p.w_f2 = (const float*)d_in[15]; p.ln2_g = (const float*)d_in[16]; p.ln2_b = (const float*)d_in[17];
    p.out = (float*)d_out; p.ws = (unsigned char*)d_ws;
    void* args[] = {&p};
    hipError_t e = hipLaunchCooperativeKernel((const void*)fwd_kernel, dim3(grid), dim3(NTHREADS), args, LDS_BYTES, stream);
    if (e != hipSuccess) fprintf(stderr, "kernel_launch: cooperative launch failed: %s (grid %d)\n", hipGetErrorString(e), grid);
}
```

```cpp
#include <hip/hip_runtime.h>
#include <hip/hip_cooperative_groups.h>
#include <cstdio>
#include <cstdint>
namespace cg = cooperative_groups;
namespace pg8 {
#define PG8_LAS __attribute__((address_space(3)))
typedef unsigned short bf16_t;
typedef short bf16x8 __attribute__((ext_vector_type(8)));
typedef float f32x4 __attribute__((ext_vector_type(4)));
typedef unsigned u32x4 __attribute__((ext_vector_type(4)));
constexpr int BM = 256, BK = 64, HALF = 128, HTB = HALF * BK * 2  , STAGE_BYTES = 8 * HTB, NXCD = 8, WGM = 8;

__host__ __device__ __forceinline__ int lds_byte(int r, int c) { const int st = (r >> 4) * 2 + (c >> 5), rr = r & 15, cc = c & 31, ob = rr * 64 + cc * 2; return st * 1024 + (ob ^ (((ob >> 9) & 1) << 5)); }
__host__ __device__ __forceinline__ void stage_rc(int b, int& R, int& C) { const int st = b / 1024, sb = b % 1024, swz = sb ^ (((sb >> 9) & 1) << 5); R = (st >> 1) * 16 + swz / 64; C = (st & 1) * 32 + (swz % 64) / 2; }
__host__ __device__ __forceinline__ int perm32(int rho) { const int n = rho >> 4, i = rho & 15; return 8 * (i >> 2) + 4 * n + (i & 3); }

struct Unit { int pm, pn; };
struct Gemm { const bf16_t* A; const bf16_t* Bt; int M, N, K; };

struct StaticOrder {
    int nM, nN, nwg, G, c;
    __host__ __device__ void init(int M, int N, int G_, int c_) { nM = M / BM; nN = N / BM; nwg = nM * nN; G = G_; c = c_; }
    __host__ __device__ bool next(int i, Unit& u) const {
        const long L = (long)i * G + c; if (L >= nwg) return false;
        int wgid = (int)L; { const int q = nwg / NXCD, r = nwg % NXCD, xcd = wgid % NXCD, off = wgid / NXCD; wgid = (xcd < r ? xcd * (q + 1) : r * (q + 1) + (xcd - r) * q) + off; }
        const int nig = WGM * nN, gid = wgid / nig, fm = gid * WGM, gsz = (nM - fm) < WGM ? (nM - fm) : WGM;
        u.pm = fm + ((wgid % nig) % gsz); u.pn = (wgid % nig) / gsz; return true;
    }
    __device__ __forceinline__ void a_ready(const Unit&) const {}
    __device__ __forceinline__ void done(const Unit&) const {}
};

__device__ __forceinline__ unsigned cvt_pk_bf16(float lo, float hi) { unsigned r; asm volatile("v_cvt_pk_bf16_f32 %0, %1, %2" : "=v"(r) : "v"(lo), "v"(hi)); return r; }
typedef float f32x2 __attribute__((ext_vector_type(2)));
typedef unsigned u32x2 __attribute__((ext_vector_type(2)));
__device__ __forceinline__ float bfbits2f(unsigned short b) { return __builtin_bit_cast(float, (unsigned)b << 16); }
__device__ __forceinline__ float sigmoidf_(float v) { return __builtin_amdgcn_rcpf(1.0f + __builtin_amdgcn_exp2f(-1.4426950408889634f * v)); }
template <int ACT> struct EpiBf16 {
    static constexpr bool PERM = true, AFTER_DRAIN = false;
    bf16_t* O; int ldc;
    __device__ __forceinline__ void operator()(const f32x4 (&acc)[2][2][4][2], const Unit& u, int wr, int wc, int fr, int fq) const {
        const int row0 = u.pm * BM + wr * 64 + fr; const int col0 = u.pn * BM + wc * 32 + 8 * fq;
#pragma unroll
        for (int ai = 0; ai < 2; ++ai)
#pragma unroll
            for (int m = 0; m < 4; ++m) { bf16_t* rowp = O + (size_t)(row0 + ai * HALF + m * 16) * ldc + col0;
#pragma unroll
                for (int bj = 0; bj < 2; ++bj) { f32x4 v0 = acc[ai][bj][m][0], v1 = acc[ai][bj][m][1];
                    if (ACT == 2) {
#pragma unroll
                        for (int i = 0; i < 4; ++i) { float a = __builtin_fmaxf(v0[i], 0.f), b = __builtin_fmaxf(v1[i], 0.f); v0[i] = a * a; v1[i] = b * b; } }
                    u32x4 w; w.x = cvt_pk_bf16(v0[0], v0[1]); w.y = cvt_pk_bf16(v0[2], v0[3]); w.z = cvt_pk_bf16(v1[0], v1[1]); w.w = cvt_pk_bf16(v1[2], v1[3]);
                    *(u32x4*)(rowp + bj * HALF) = w; } }
    }
};
struct EpiGate1 {
    static constexpr bool PERM = false, AFTER_DRAIN = false;
    float* T; const bf16_t* G; int ldg; const float* gb;
    __device__ __forceinline__ void operator()(const f32x4 (&acc)[2][2][4][2], const Unit& u, int wr, int wc, int fr, int fq) const {
        const int row0 = u.pm * BM + wr * 64 + fr; const int col0 = u.pn * BM + wc * 32 + 4 * fq;
#pragma unroll
        for (int bj = 0; bj < 2; ++bj)
#pragma unroll
            for (int n = 0; n < 2; ++n) { const int col = col0 + bj * HALF + n * 16; const f32x4 bv = *(const f32x4*)(gb + col);
#pragma unroll
                for (int ai = 0; ai < 2; ++ai)
#pragma unroll
                    for (int m = 0; m < 4; ++m) { const size_t row = (size_t)(row0 + ai * HALF + m * 16);
                        const u32x2 g = *(const u32x2*)(G + row * ldg + col); const f32x4 a = acc[ai][bj][m][n]; f32x4 o;
                        o[0] = sigmoidf_(__builtin_bit_cast(float, g.x << 16) + bv[0]) * a[0]; o[1] = sigmoidf_(__builtin_bit_cast(float, g.x & 0xffff0000u) + bv[1]) * a[1];
                        o[2] = sigmoidf_(__builtin_bit_cast(float, g.y << 16) + bv[2]) * a[2]; o[3] = sigmoidf_(__builtin_bit_cast(float, g.y & 0xffff0000u) + bv[3]) * a[3];
                        *(f32x4*)(T + row * 1024 + col) = o; } }
    }
};
struct EpiGate2 {
    static constexpr bool PERM = false, AFTER_DRAIN = false;
    const float* T; bf16_t* O; const bf16_t* G; int ldg; const float* gb;
    __device__ __forceinline__ void operator()(const f32x4 (&acc)[2][2][4][2], const Unit& u, int wr, int wc, int fr, int fq) const {
        const int row0 = u.pm * BM + wr * 64 + fr; const int col0 = u.pn * BM + wc * 32 + 4 * fq;
#pragma unroll
        for (int bj = 0; bj < 2; ++bj)
#pragma unroll
            for (int n = 0; n < 2; ++n) { const int col = col0 + bj * HALF + n * 16; const f32x4 bv = *(const f32x4*)(gb + col);
#pragma unroll
                for (int ai = 0; ai < 2; ++ai)
#pragma unroll
                    for (int m = 0; m < 4; ++m) { const size_t row = (size_t)(row0 + ai * HALF + m * 16);
                        const u32x2 g = *(const u32x2*)(G + row * ldg + col); const f32x4 t = *(const f32x4*)(T + row * 1024 + col); const f32x4 a = acc[ai][bj][m][n]; f32x4 o;
                        o[0] = t[0] + sigmoidf_(__builtin_bit_cast(float, g.x << 16) + bv[0]) * a[0]; o[1] = t[1] + sigmoidf_(__builtin_bit_cast(float, g.x & 0xffff0000u) + bv[1]) * a[1];
                        o[2] = t[2] + sigmoidf_(__builtin_bit_cast(float, g.y << 16) + bv[2]) * a[2]; o[3] = t[3] + sigmoidf_(__builtin_bit_cast(float, g.y & 0xffff0000u) + bv[3]) * a[3];
                        u32x2 w; w.x = cvt_pk_bf16(o[0], o[1]); w.y = cvt_pk_bf16(o[2], o[3]);
                        *(u32x2*)(O + row * 1024 + col) = w; } }
    }
};
struct EpiResid {
    static constexpr bool PERM = false, AFTER_DRAIN = false;
    const float* base; float* out; float alpha;
    __device__ __forceinline__ void operator()(const f32x4 (&acc)[2][2][4][2], const Unit& u, int wr, int wc, int fr, int fq) const {
        const int row0 = u.pm * BM + wr * 64 + fr; const int col0 = u.pn * BM + wc * 32 + 4 * fq;
#pragma unroll
        for (int ai = 0; ai < 2; ++ai)
#pragma unroll
            for (int m = 0; m < 4; ++m) { const size_t row = (size_t)(row0 + ai * HALF + m * 16);
#pragma unroll
                for (int bj = 0; bj < 2; ++bj)
#pragma unroll
                    for (int n = 0; n < 2; ++n) { const int col = col0 + bj * HALF + n * 16;
                        const f32x4 b = *(const f32x4*)(base + row * 1024 + col); const f32x4 a = acc[ai][bj][m][n];
                        *(f32x4*)(out + row * 1024 + col) = b * alpha + a; } }
    }
};

template <class Epi, class Sched, bool ALIGN_EPI = false, bool SP2 = false>
__device__ __forceinline__ void gemm_phase(PG8_LAS unsigned char* lds, const Gemm g, const Sched& S, const Epi& E) {
    const int tid = threadIdx.x, wid = __builtin_amdgcn_readfirstlane(tid >> 6), lane = tid & 63, wr = wid >> 2, wc = wid & 3, fr = lane & 15, fq = lane >> 4;
    const int K = g.K, nt = K / BK;
    unsigned voffA[2], voffB[2];
#pragma unroll
    for (int i = 0; i < 2; ++i) { int R, C; stage_rc(tid * 16 + i * 8192, R, C); const int Rb = Epi::PERM ? ((R & ~31) + perm32(R & 31)) : R;
        voffA[i] = (unsigned)(R * K + C) * 2u; voffB[i] = (unsigned)(Rb * K + C) * 2u; }
    const size_t kstep = (size_t)(BK * 2);
    const size_t hstep = (size_t)HALF * K * 2;
    const size_t tstep = 2 * hstep;
    const unsigned ldsw = (unsigned)wid * 1024u;
    const int aoff = lds_byte(wr * 64 + fr, fq * 8), boff = lds_byte(wc * 32 + fr, fq * 8);
#define PG8_SA(b, h) (((b) * 2 + (h)) * HTB)
#define PG8_SB(b, h) ((4 + (b) * 2 + (h)) * HTB)
#define PG8_STAGE(bufoff, gbase, voff) do { _Pragma("unroll") for (int _i = 0; _i < 2; ++_i) \
        __builtin_amdgcn_global_load_lds((const unsigned*)((const char*)(gbase) + (voff)[_i]), (PG8_LAS unsigned*)(lds + (bufoff) + ldsw + _i * 8192), 16, 0, 0); } while (0)
#define PG8_LDA(dst, b, h) do { _Pragma("unroll") for (int m = 0; m < 4; ++m) _Pragma("unroll") for (int k = 0; k < 2; ++k) dst[m][k] = *(const PG8_LAS bf16x8*)(lds + PG8_SA(b, h) + aoff + m * 2048 + k * 1024); } while (0)
#define PG8_LDB(dst, b, h) do { _Pragma("unroll") for (int n = 0; n < 2; ++n) _Pragma("unroll") for (int k = 0; k < 2; ++k) dst[n][k] = *(const PG8_LAS bf16x8*)(lds + PG8_SB(b, h) + boff + n * 2048 + k * 1024); } while (0)
#define PG8_MMA(ai, bj, At, Bt) do { __builtin_amdgcn_s_setprio(1); _Pragma("unroll") for (int m = 0; m < 4; ++m) _Pragma("unroll") for (int n = 0; n < 2; ++n) _Pragma("unroll") for (int k = 0; k < 2; ++k) \
        acc[ai][bj][m][n] = __builtin_amdgcn_mfma_f32_16x16x32_bf16(Bt[n][k], At[m][k], acc[ai][bj][m][n], 0, 0, 0); __builtin_amdgcn_s_setprio(0); } while (0)
#define PG8_WAIT_V(n) asm volatile("s_waitcnt vmcnt(" #n ")" ::: "memory")
#define PG8_WAIT_L(n) asm volatile("s_waitcnt lgkmcnt(" #n ")" ::: "memory")
#define PG8_BAR __builtin_amdgcn_s_barrier()
#define PG8_SCHED __builtin_amdgcn_sched_barrier(0)
    Unit cur, nxt; int ui = 0;
    if (!S.next(0, cur)) return;
    f32x4 acc[2][2][4][2];
#pragma unroll
    for (int a = 0; a < 2; ++a)
#pragma unroll
        for (int b = 0; b < 2; ++b)
#pragma unroll
            for (int m = 0; m < 4; ++m)
#pragma unroll
                for (int n = 0; n < 2; ++n) acc[a][b][m][n] = (f32x4){0.f, 0.f, 0.f, 0.f};
    bf16x8 At[4][2], B0[2][2], B1[2][2];
    const char* cA = (const char*)g.A + (size_t)cur.pm * tstep; const char* cB = (const char*)g.Bt + (size_t)cur.pn * tstep;
    S.a_ready(cur);
    if constexpr (SP2) {
        PG8_STAGE(PG8_SB(0, 0), cB, voffB); PG8_STAGE(PG8_SB(0, 1), cB + hstep, voffB); PG8_STAGE(PG8_SA(0, 0), cA, voffA); PG8_STAGE(PG8_SA(0, 1), cA + hstep, voffA);
        if (wr == 1) PG8_BAR;
        PG8_WAIT_V(2); PG8_BAR;
        PG8_STAGE(PG8_SB(1, 0), cB + kstep, voffB); PG8_STAGE(PG8_SA(1, 0), cA + kstep, voffA); PG8_STAGE(PG8_SB(1, 1), cB + hstep + kstep, voffB);
        PG8_WAIT_V(6); PG8_BAR;
    } else {
        PG8_STAGE(PG8_SB(0, 0), cB, voffB); PG8_STAGE(PG8_SA(0, 0), cA, voffA); PG8_STAGE(PG8_SB(0, 1), cB + hstep, voffB); PG8_STAGE(PG8_SA(0, 1), cA + hstep, voffA);
        if (wr == 1) PG8_BAR;
        PG8_WAIT_V(4); PG8_BAR;
        PG8_STAGE(PG8_SB(1, 0), cB + kstep, voffB); PG8_STAGE(PG8_SA(1, 0), cA + kstep, voffA); PG8_STAGE(PG8_SB(1, 1), cB + hstep + kstep, voffB);
        PG8_WAIT_V(6); PG8_BAR;
    }
    for (;;) {
        const bool has_next = S.next(ui + 1, nxt);
        const char* nA = has_next ? (const char*)g.A + (size_t)nxt.pm * tstep : cA; const char* nB = has_next ? (const char*)g.Bt + (size_t)nxt.pn * tstep : cB;
        for (int t = 0; t < nt; t += 2) {
            const bool last = (t == nt - 2);
            const char* a1 = cA + (size_t)(t + 1) * kstep;
            const char* a2 = last ? nA : cA + (size_t)(t + 2) * kstep; const char* b2 = last ? nB : cB + (size_t)(t + 2) * kstep;
            const char* a3 = a2 + kstep; const char* b3 = b2 + kstep;
            if (last && has_next) S.a_ready(nxt);
            if constexpr (SP2) {
            PG8_LDB(B0, 0, 0); PG8_LDB(B1, 0, 1); PG8_SCHED; PG8_LDA(At, 0, 0); PG8_STAGE(PG8_SA(1, 1), a1 + hstep, voffA);
            PG8_WAIT_V(8); PG8_WAIT_L(0); PG8_BAR; PG8_MMA(0, 0, At, B0); PG8_MMA(0, 1, At, B1); PG8_BAR; PG8_SCHED;
            PG8_LDA(At, 0, 1); PG8_STAGE(PG8_SB(0, 0), b2, voffB); PG8_STAGE(PG8_SB(0, 1), b2 + hstep, voffB); PG8_STAGE(PG8_SA(0, 0), a2, voffA);
            PG8_WAIT_V(8); PG8_WAIT_L(0); PG8_BAR; PG8_MMA(1, 0, At, B0); PG8_MMA(1, 1, At, B1); PG8_BAR; PG8_SCHED;
            PG8_LDB(B0, 1, 0); PG8_LDB(B1, 1, 1); PG8_SCHED; PG8_LDA(At, 1, 0); PG8_STAGE(PG8_SA(0, 1), a2 + hstep, voffA);
            PG8_WAIT_V(8); PG8_WAIT_L(0); PG8_BAR; PG8_MMA(0, 0, At, B0); PG8_MMA(0, 1, At, B1); PG8_BAR; PG8_SCHED;
            PG8_LDA(At, 1, 1); PG8_STAGE(PG8_SB(1, 0), b3, voffB); PG8_STAGE(PG8_SB(1, 1), b3 + hstep, voffB); PG8_STAGE(PG8_SA(1, 0), a3, voffA);
            PG8_WAIT_V(8); PG8_WAIT_L(0); PG8_BAR; PG8_MMA(1, 0, At, B0); PG8_MMA(1, 1, At, B1); PG8_BAR; PG8_SCHED;
            } else {
            PG8_LDB(B0, 0, 0); PG8_SCHED; PG8_LDA(At, 0, 0); PG8_STAGE(PG8_SA(1, 1), a1 + hstep, voffA);
            PG8_WAIT_L(8); PG8_BAR; PG8_WAIT_L(0); PG8_MMA(0, 0, At, B0); PG8_BAR; PG8_SCHED;
            PG8_LDB(B1, 0, 1); PG8_STAGE(PG8_SB(0, 0), b2, voffB);
            PG8_BAR; PG8_WAIT_L(0); PG8_MMA(0, 1, At, B1); PG8_BAR;
            PG8_LDA(At, 0, 1); PG8_STAGE(PG8_SA(0, 0), a2, voffA);
            PG8_BAR; PG8_WAIT_L(0); PG8_MMA(1, 0, At, B0); PG8_BAR; PG8_SCHED;
            PG8_STAGE(PG8_SB(0, 1), b2 + hstep, voffB);
            PG8_WAIT_V(6); PG8_BAR; PG8_MMA(1, 1, At, B1); PG8_BAR;
            PG8_LDB(B0, 1, 0); PG8_SCHED; PG8_LDA(At, 1, 0); PG8_STAGE(PG8_SA(0, 1), a2 + hstep, voffA);
            PG8_WAIT_L(8); PG8_BAR; PG8_WAIT_L(0); PG8_MMA(0, 0, At, B0); PG8_BAR; PG8_SCHED;
            PG8_LDB(B1, 1, 1); PG8_STAGE(PG8_SB(1, 0), b3, voffB);
            PG8_BAR; PG8_WAIT_L(0); PG8_MMA(0, 1, At, B1); PG8_BAR;
            PG8_LDA(At, 1, 1); PG8_STAGE(PG8_SA(1, 0), a3, voffA);
            PG8_BAR; PG8_WAIT_L(0); PG8_MMA(1, 0, At, B0); PG8_BAR; PG8_SCHED;
            PG8_STAGE(PG8_SB(1, 1), b3 + hstep, voffB);
            PG8_WAIT_V(6); PG8_BAR; PG8_MMA(1, 1, At, B1); PG8_BAR;
            }
        }
        if constexpr (ALIGN_EPI) { if (wr == 0) PG8_BAR; }
        if constexpr (!Epi::AFTER_DRAIN) { E(acc, cur, wr, wc, fr, fq); S.done(cur); }
        if (!has_next) break;
#pragma unroll
        for (int a = 0; a < 2; ++a)
#pragma unroll
            for (int b = 0; b < 2; ++b)
#pragma unroll
                for (int m = 0; m < 4; ++m)
#pragma unroll
                    for (int n = 0; n < 2; ++n) acc[a][b][m][n] = (f32x4){0.f, 0.f, 0.f, 0.f};
        cur = nxt; cA = nA; cB = nB; ++ui;
        if constexpr (ALIGN_EPI) { if (wr == 1) PG8_BAR; }
    }
    PG8_WAIT_V(0);
    if constexpr (!ALIGN_EPI) { if (wr == 0) PG8_BAR; }
    PG8_BAR;
    if constexpr (Epi::AFTER_DRAIN) { E.fused(acc, cur, wr, wc, fr, fq, lds, wid, lane); S.done(cur); }
#undef PG8_SA
#undef PG8_SB
#undef PG8_STAGE
#undef PG8_LDA
#undef PG8_LDB
#undef PG8_MMA
#undef PG8_WAIT_V
#undef PG8_WAIT_L
#undef PG8_BAR
#undef PG8_SCHED
}
}

#define GAS __attribute__((address_space(1)))
#define LAS __attribute__((address_space(3)))
typedef unsigned short bf16;
typedef unsigned v4u __attribute__((ext_vector_type(4)));
typedef unsigned v2u __attribute__((ext_vector_type(2)));
typedef float f32x4 __attribute__((ext_vector_type(4)));
typedef float f32x16 __attribute__((ext_vector_type(16)));
typedef short bf16x8 __attribute__((ext_vector_type(8)));
typedef short s16x4 __attribute__((ext_vector_type(4)));
typedef unsigned long long u64;

constexpr int NB = 8, SEQ = 4096, M = NB * SEQ, DM = 1024, DC = 512, DA = 512, NH = 8, HD = 64, FF = 4096;
constexpr int NIN = 5192, NPROJ = 5376;
constexpr int PC_A = 0, PC_B = 512, PC_Q = 1024, PC_K = 1536, PC_V = 2048, PC_QI = 2560, PC_GC = 3072, PC_GA = 4096, PC_KI = 5120, PC_WI = 5184;
constexpr float LN_EPS = 1e-5f;
constexpr float DN_ALPHA = 1.189207115002721f;
constexpr float C2 = 0.125f * 1.4426950408889634f;
constexpr int NWAVES = 8, NTHREADS = 512;
constexpr int LDS_BYTES = 147456;
constexpr int MISC_OFF = 131072 + 320;
constexpr int CW_BAR = 4096;
constexpr size_t CTL_ZERO_BYTES = 65536;

constexpr size_t MiB = 1u << 20;
constexpr size_t WS_CTL = 0;
constexpr size_t WS_WIN = 1 * MiB, WS_WCO = 12 * MiB, WS_WAO = 13 * MiB, WS_WO = 14 * MiB, WS_WF1 = 16 * MiB, WS_WF2 = 24 * MiB;
constexpr size_t WS_PROJ = 32 * MiB;
constexpr size_t WS_XB = 368 * MiB;
constexpr size_t WS_CU = 432 * MiB;
constexpr size_t WS_AT = 464 * MiB;
constexpr size_t WS_X1 = 32 * MiB;
constexpr size_t WS_X1B = 160 * MiB;
constexpr size_t WS_H = 224 * MiB;
constexpr size_t WS_END = 512 * MiB;
constexpr size_t DO_BM = 0, DO_KIR = 16 * MiB, DO_WIS = 20 * MiB;

__device__ __forceinline__ unsigned f2bf(float f) { unsigned u = __builtin_bit_cast(unsigned, f); return (u + 0x7fffu + ((u >> 16) & 1u)) >> 16; }
__device__ __forceinline__ unsigned pk2(float lo, float hi) { return f2bf(lo) | (f2bf(hi) << 16); }
__device__ __forceinline__ float bflo(unsigned w) { return __builtin_bit_cast(float, w << 16); }
__device__ __forceinline__ float bfhi(unsigned w) { return __builtin_bit_cast(float, w & 0xffff0000u); }
__device__ __forceinline__ float bf2f(bf16 b) { return __builtin_bit_cast(float, (unsigned)b << 16); }
__device__ __forceinline__ float wave_sum(float v) {
#pragma unroll
    for (int o = 1; o < 64; o <<= 1) v += __shfl_xor(v, o);
    return v;
}
__device__ __forceinline__ float sigm(float v) { return __builtin_amdgcn_rcpf(1.0f + __builtin_amdgcn_exp2f(-1.4426950408889634f * v)); }
__device__ __forceinline__ int crow(int r, int hi) { return (r & 3) + 8 * (r >> 2) + 4 * hi; }
#define LDS_WAIT() asm volatile("s_waitcnt lgkmcnt(0)" ::: "memory")

struct Params {
    const float* x; const float* w_in; const float* dw_w; const float* dw_b; const float* cln_g; const float* cln_b; const float* w_co;
    const float* kln_g; const float* kln_b; const float* w_ao; const float* gate_b; const float* w_o; const float* ln1_g; const float* ln1_b;
    const float* w_f1; const float* w_f2; const float* ln2_g; const float* ln2_b;
    float* out; unsigned char* ws;
};

__device__ __forceinline__ int win_src_col(int n) { return n < 3072 ? n : (n < 5120 ? n + 72 : (n < 5192 ? n - 2048 : -1)); }
template <bool MAPWIN>
__device__ __forceinline__ void transpose_item(const float* W, int K, int Nsrc, int Nnew, bf16* WT, LAS float* scr, int item, int lane) {
    const int nblk = Nnew / 32, kb = item / nblk, nb = item % nblk, k0 = 64 * kb, n0 = 32 * nb;
    const int nn = n0 + (lane & 31); const int sc = MAPWIN ? win_src_col(nn) : nn;
#pragma unroll 8
    for (int i = 0; i < 32; ++i) { const int kk = 2 * i + (lane >> 5); scr[kk * 33 + (lane & 31)] = sc >= 0 ? W[(size_t)(k0 + kk) * Nsrc + sc] : 0.f; }
    LDS_WAIT(); asm volatile("" ::: "memory");
    const int c = lane & 7;
#pragma unroll
    for (int j = 0; j < 4; ++j) { const int n = (lane >> 3) + 8 * j; const LAS float* s = scr + (8 * c) * 33 + n;
        v4u o; o.x = pk2(s[0 * 33], s[1 * 33]); o.y = pk2(s[2 * 33], s[3 * 33]); o.z = pk2(s[4 * 33], s[5 * 33]); o.w = pk2(s[6 * 33], s[7 * 33]);
        *(v4u*)(WT + (size_t)(n0 + n) * K + k0 + 8 * c) = o; }
    LDS_WAIT(); asm volatile("" ::: "memory");
}
__device__ __forceinline__ void phase0(const Params& p, LAS unsigned char* lds, int gw, int NGW, int wave, int lane) {
    LAS float* scr = (LAS float*)(lds + wave * 16384);
    bf16* WinT = (bf16*)(p.ws + WS_WIN); bf16* WcoT = (bf16*)(p.ws + WS_WCO); bf16* WaoT = (bf16*)(p.ws + WS_WAO); bf16* WoT = (bf16*)(p.ws + WS_WO);
    bf16* Wf1T = (bf16*)(p.ws + WS_WF1); bf16* Wf2T = (bf16*)(p.ws + WS_WF2);
    constexpr int I_IN = (DM / 64) * (NPROJ / 32), I_CO = (DC / 64) * (DM / 32), I_AO = I_CO, I_O = (DM / 64) * (DM / 32), I_F1 = (DM / 64) * (FF / 32), I_F2 = (FF / 64) * (DM / 32);
    constexpr int NITEMS = I_IN + I_CO + I_AO + I_O + I_F1 + I_F2;
    for (int it = gw; it < NITEMS; it += NGW) {
        int r = it;
        if (r < I_IN) { transpose_item<true>(p.w_in, DM, NIN, NPROJ, WinT, scr, r, lane); continue; } r -= I_IN;
        if (r < I_CO) { transpose_item<false>(p.w_co, DC, DM, DM, WcoT, scr, r, lane); continue; } r -= I_CO;
        if (r < I_AO) { transpose_item<false>(p.w_ao, DA, DM, DM, WaoT, scr, r, lane); continue; } r -= I_AO;
        if (r < I_O) { transpose_item<false>(p.w_o, DM, DM, DM, WoT, scr, r, lane); continue; } r -= I_O;
        if (r < I_F1) { transpose_item<false>(p.w_f1, DM, FF, FF, Wf1T, scr, r, lane); continue; } r -= I_F1;
        transpose_item<false>(p.w_f2, FF, DM, DM, Wf2T, scr, r, lane);
    }
    bf16* xb = (bf16*)(p.ws + WS_XB);
    for (int m = gw; m < M; m += NGW) {
        const f32x4* xr = (const f32x4*)(p.x + (size_t)m * DM) + lane; u64* o8 = (u64*)(xb + (size_t)m * DM) + lane;
#pragma unroll
        for (int j = 0; j < 4; ++j) { const f32x4 v = xr[64 * j]; o8[64 * j] = (u64)pk2(v[0], v[1]) | ((u64)pk2(v[2], v[3]) << 32); }
    }
}

__device__ __forceinline__ void rope8(v4u& w, const float* cs, const float* sn, bool second, float scale) {
    v4u pw; pw.x = __shfl_xor(w.x, 4); pw.y = __shfl_xor(w.y, 4); pw.z = __shfl_xor(w.z, 4); pw.w = __shfl_xor(w.w, 4);
    float own[8] = {bflo(w.x), bfhi(w.x), bflo(w.y), bfhi(w.y), bflo(w.z), bfhi(w.z), bflo(w.w), bfhi(w.w)};
    float oth[8] = {bflo(pw.x), bfhi(pw.x), bflo(pw.y), bfhi(pw.y), bflo(pw.z), bfhi(pw.z), bflo(pw.w), bfhi(pw.w)};
    float o[8];
#pragma unroll
    for (int i = 0; i < 8; ++i) o[i] = (second ? (own[i] * cs[i] + oth[i] * sn[i]) : (own[i] * cs[i] - oth[i] * sn[i])) * scale;
    w.x = pk2(o[0], o[1]); w.y = pk2(o[2], o[3]); w.z = pk2(o[4], o[5]); w.w = pk2(o[6], o[7]);
}
__device__ __forceinline__ void sincos_rev(float ang, float& s, float& c) {
    double t = (double)ang * 0.15915494309189535; t -= __builtin_rint(t); const float rev = (float)t;
    s = __builtin_amdgcn_sinf(rev); c = __builtin_amdgcn_cosf(rev);
}
__device__ __forceinline__ void phase2a(const Params& p, int gw, int NGW, int lane) {
    bf16* proj = (bf16*)(p.ws + WS_PROJ);
    bf16* kir = (bf16*)((unsigned char*)p.out + DO_KIR); float* wis = (float*)((unsigned char*)p.out + DO_WIS);
    float invf[8];
#pragma unroll
    for (int i = 0; i < 8; ++i) invf[i] = (float)::exp2(-(double)((lane & 3) * 8 + i) * (13.287712379549449 / 32.0));
    const float invf1 = (float)::exp2(-(double)(lane & 31) * (13.287712379549449 / 32.0));
    const float kg = p.kln_g[lane], kb = p.kln_b[lane];
    const bool second = (lane & 7) >= 4;
    for (int tok = gw; tok < M; tok += NGW) {
        bf16* row = proj + (size_t)tok * NPROJ; const float pos = (float)(tok & (SEQ - 1));
        float cs[8], sn[8];
#pragma unroll
        for (int i = 0; i < 8; ++i) sincos_rev(pos * invf[i], sn[i], cs[i]);
        v4u q = *(const v4u*)(row + PC_Q + lane * 8), k = *(const v4u*)(row + PC_K + lane * 8), qi = *(const v4u*)(row + PC_QI + lane * 8);
        const float kiv = bf2f(row[PC_KI + lane]);
        const float wv = lane < 8 ? bf2f(row[PC_WI + lane]) : 0.f;
        rope8(q, cs, sn, second, C2); rope8(k, cs, sn, second, 1.f); rope8(qi, cs, sn, second, 1.f);
        *(v4u*)(row + PC_Q + lane * 8) = q; *(v4u*)(row + PC_K + lane * 8) = k; *(v4u*)(row + PC_QI + lane * 8) = qi;
        const float mean = wave_sum(kiv) * (1.f / 64.f); const float d = kiv - mean; const float var = wave_sum(d * d) * (1.f / 64.f);
        const float y = d * (1.0f / sqrtf(var + LN_EPS)) * kg + kb;
        float s1, c1; sincos_rev(pos * invf1, s1, c1);
        const float oth = __shfl_xor(y, 32);
        const float yo = lane < 32 ? (y * c1 - oth * s1) : (y * c1 + oth * s1);
        kir[(size_t)tok * 64 + lane] = (bf16)f2bf(yo);
        if (lane < 8) wis[(size_t)tok * 8 + lane] = wv * 0.04419417382415922f;
    }
}

__device__ __forceinline__ void phase2b(const Params& p, LAS unsigned char* lds, int bid, int nblk, int tid, int wave, int lane) {
    const bf16* proj = (const bf16*)(p.ws + WS_PROJ); bf16* cu = (bf16*)(p.ws + WS_CU);
    LAS float* U = (LAS float*)lds;
    float w[31];
#pragma unroll
    for (int j = 0; j < 31; ++j) w[j] = p.dw_w[j * DC + tid];
    const float bias = p.dw_b[tid];
    constexpr int TT = 32, NTILE = M / TT;
    for (int tile = bid; tile < NTILE; tile += nblk) {
        const int tok0 = tile * TT; const int t0 = tok0 & (SEQ - 1);
        __syncthreads();
        for (int r = (tid >> 6); r < 62; r += 8) {
            const int c8 = (tid & 63) * 8; f32x4 u0 = {0.f, 0.f, 0.f, 0.f}, u1 = {0.f, 0.f, 0.f, 0.f};
            if (t0 - 30 + r >= 0) {
                const bf16* row = proj + (size_t)(tok0 - 30 + r) * NPROJ;
                const v4u a = *(const v4u*)(row + PC_A + c8), b = *(const v4u*)(row + PC_B + c8);
                u0[0] = bflo(a.x) * sigm(bflo(b.x)); u0[1] = bfhi(a.x) * sigm(bfhi(b.x)); u0[2] = bflo(a.y) * sigm(bflo(b.y)); u0[3] = bfhi(a.y) * sigm(bfhi(b.y));
                u1[0] = bflo(a.z) * sigm(bflo(b.z)); u1[1] = bfhi(a.z) * sigm(bfhi(b.z)); u1[2] = bflo(a.w) * sigm(bflo(b.w)); u1[3] = bfhi(a.w) * sigm(bfhi(b.w));
            }
            *(LAS f32x4*)(U + r * DC + c8) = u0; *(LAS f32x4*)(U + r * DC + c8 + 4) = u1;
        }
        __syncthreads();
        float o[TT];
#pragma unroll
        for (int t = 0; t < TT; ++t) o[t] = bias;
#pragma unroll
        for (int r = 0; r < 62; ++r) { const float v = U[r * DC + tid];
#pragma unroll
            for (int t = 0; t < TT; ++t) { if (r - t >= 0 && r - t <= 30) o[t] += w[r - t] * v; } }
#pragma unroll
        for (int t = 0; t < TT; ++t) U[t * DC + tid] = o[t];
        __syncthreads();
#pragma unroll
        for (int i = 0; i < 4; ++i) { const int t = wave * 4 + i;
            const f32x4 a = *(const LAS f32x4*)(U + t * DC + lane * 8), b = *(const LAS f32x4*)(U + t * DC + lane * 8 + 4);
            const float mean = wave_sum((a[0] + a[1]) + (a[2] + a[3]) + (b[0] + b[1]) + (b[2] + b[3])) * (1.f / DC);
            const f32x4 da = a - mean, db = b - mean;
            const float var = wave_sum((da[0] * da[0] + da[1] * da[1]) + (da[2] * da[2] + da[3] * da[3]) + (db[0] * db[0] + db[1] * db[1]) + (db[2] * db[2] + db[3] * db[3])) * (1.f / DC);
            const float rstd = 1.0f / sqrtf(var + LN_EPS);
            const f32x4 g0 = *(const f32x4*)(p.cln_g + lane * 8), g1 = *(const f32x4*)(p.cln_g + lane * 8 + 4), b0 = *(const f32x4*)(p.cln_b + lane * 8), b1 = *(const f32x4*)(p.cln_b + lane * 8 + 4);
            float y[8];
#pragma unroll
            for (int e = 0; e < 4; ++e) { y[e] = da[e] * rstd * g0[e] + b0[e]; y[4 + e] = db[e] * rstd * g1[e] + b1[e]; }
#pragma unroll
            for (int e = 0; e < 8; ++e) y[e] = y[e] * sigm(y[e]);
            v4u ov; ov.x = pk2(y[0], y[1]); ov.y = pk2(y[2], y[3]); ov.z = pk2(y[4], y[5]); ov.w = pk2(y[6], y[7]);
            *(v4u*)(cu + (size_t)(tok0 + t) * DC + lane * 8) = ov; }
    }
}

__device__ __forceinline__ unsigned mono(float f) { const unsigned b = __builtin_bit_cast(unsigned, f); return (b & 0x80000000u) ? ~b : (b | 0x80000000u); }
template <int NVMAX>
__device__ __forceinline__ u64 select_row(const LAS float* sc, int S, int lane) {
    unsigned u[NVMAX];
#pragma unroll
    for (int j = 0; j < NVMAX; ++j) u[j] = (j * 64 < S) ? mono(sc[j * 64 + lane]) : 0u;
    unsigned T = 0u; bool exact = false;
    for (int bit = 31; bit >= 0; --bit) {
        const unsigned cand = T | (1u << bit); int cnt = 0;
#pragma unroll
        for (int j = 0; j < NVMAX; ++j) cnt += __popcll(__ballot(u[j] >= cand));
        if (cnt >= 256) { T = cand; if (cnt == 256) { exact = true; break; } }
    }
    u64 mine = 0ull;
    bool ties = false;
    if (!exact) { int cge = 0;
#pragma unroll
        for (int j = 0; j < NVMAX; ++j) cge += __popcll(__ballot(u[j] >= T));
        ties = cge > 256; }
    if (!ties) {
#pragma unroll
        for (int j = 0; j < NVMAX; ++j) { const u64 mk = __ballot(u[j] >= T); if (lane == j) mine = mk; }
    } else {
        int cgt = 0;
#pragma unroll
        for (int j = 0; j < NVMAX; ++j) cgt += __popcll(__ballot(u[j] > T));
        int need = 256 - cgt;
#pragma unroll
        for (int j = 0; j < NVMAX; ++j) { const u64 gt = __ballot(u[j] > T); u64 eq = __ballot(u[j] == T);
            int k = __popcll(eq);
            if (k > need) { u64 kept = 0ull; for (int i = 0; i < need; ++i) { const u64 low = eq & (0ull - eq); kept |= low; eq ^= low; } eq = kept; k = need; }
            need -= k; const u64 mk = gt | eq; if (lane == j) mine = mk; }
    }
    return mine;
}
__device__ __forceinline__ void idx_tile(const Params& p, LAS unsigned char* lds, int b, int c, int sub, int tid, int wave, int lane) {
    const bf16* proj = (const bf16*)(p.ws + WS_PROJ);
    const bf16* kir = (const bf16*)((const unsigned char*)p.out + DO_KIR); const float* wis = (const float*)((const unsigned char*)p.out + DO_WIS);
    u64* bm = (u64*)((unsigned char*)p.out + DO_BM);
    const int S = 64 * (c + 1); const size_t rowbase = (size_t)b * SEQ; const size_t q0 = rowbase + c * 64 + sub * 8;
    if (c < 4) {
        u64* o = bm + (q0 + wave) * 64; o[lane] = (lane < c + 1) ? ~0ull : 0ull; return;
    }
    LAS float* SC = (LAS float*)lds;
    const int r = lane & 31, h = lane >> 5;
    {
        const int hh = (r >> 2) & 1, reg = (r & 3) + 4 * (r >> 3), ql = (reg >> 3) + 2 * hh, head = reg & 7;
        bf16x8 af[2][4]; float wv[2][2][8];
#pragma unroll
        for (int rb = 0; rb < 2; ++rb) { const bf16* src = proj + (q0 + rb * 4 + ql) * NPROJ + PC_QI + head * 64 + 32 * h;
#pragma unroll
            for (int s = 0; s < 4; ++s) af[rb][s] = *(const bf16x8*)(src + 8 * s);
#pragma unroll
            for (int e = 0; e < 2; ++e) { const float* wsrc = wis + (q0 + rb * 4 + 2 * h + e) * 8; const f32x4 w0 = *(const f32x4*)wsrc, w1 = *(const f32x4*)(wsrc + 4);
#pragma unroll
                for (int i = 0; i < 4; ++i) { wv[rb][e][i] = w0[i]; wv[rb][e][4 + i] = w1[i]; } } }
        const int nct = S / 32;
        for (int ct = wave; ct < nct; ct += 8) {
            const bf16* ksrc = kir + (rowbase + ct * 32 + r) * 64 + 32 * h;
            bf16x8 bfr[4];
#pragma unroll
            for (int s = 0; s < 4; ++s) bfr[s] = *(const bf16x8*)(ksrc + 8 * s);
#pragma unroll
            for (int rb = 0; rb < 2; ++rb) { f32x16 acc;
#pragma unroll
                for (int i = 0; i < 16; ++i) acc[i] = 0.f;
#pragma unroll
                for (int s = 0; s < 4; ++s) acc = __builtin_amdgcn_mfma_f32_32x32x16_bf16(af[rb][s], bfr[s], acc, 0, 0, 0);
#pragma unroll
                for (int e = 0; e < 2; ++e) { float sum = 0.f;
#pragma unroll
                    for (int i = 0; i < 8; ++i) sum += wv[rb][e][i] * __builtin_fmaxf(acc[8 * e + i], 0.f);
                    SC[(rb * 4 + 2 * h + e) * 4096 + ct * 32 + r] = sum; } }
        }
    }
    __syncthreads();
    {
        const LAS float* sc = SC + wave * 4096; u64 mine;
        if (S <= 1024) mine = select_row<16>(sc, S, lane);
        else if (S <= 2048) mine = select_row<32>(sc, S, lane);
        else if (S <= 3072) mine = select_row<48>(sc, S, lane);
        else mine = select_row<64>(sc, S, lane);
        bm[(q0 + wave) * 64 + lane] = mine;
    }
    __syncthreads();
}
__device__ __forceinline__ void phase3(const Params& p, LAS unsigned char* lds, int bid, int nblk, int tid, int wave, int lane) {
    for (int pr = bid; pr < 2048; pr += nblk) {
        const int cp = pr & 31, sub = (pr >> 5) & 7, b = pr >> 8;
        idx_tile(p, lds, b, cp, sub, tid, wave, lane);
        idx_tile(p, lds, b, 63 - cp, sub, tid, wave, lane);
    }
}

__device__ __forceinline__ s16x4 vtr(const LAS unsigned char* p) { typedef short v4i16_t __attribute__((ext_vector_type(4))); return __builtin_bit_cast(s16x4, __builtin_amdgcn_ds_read_tr16_b64_v4i16((LAS v4i16_t*)p)); }
__device__ __forceinline__ unsigned cvtpk(float lo, float hi) { unsigned r; asm volatile("v_cvt_pk_bf16_f32 %0, %1, %2" : "=v"(r) : "v"(lo), "v"(hi)); return r; }
__device__ __forceinline__ void attn_unit(const Params& p, LAS unsigned char* lds, int b, int h, int qb, int tid, int wid, int lane) {
    const bf16* proj = (const bf16*)(p.ws + WS_PROJ); const u64* bm = (const u64*)((const unsigned char*)p.out + DO_BM); bf16* attn = (bf16*)(p.ws + WS_AT);
    const int r32 = lane & 31, hi = lane >> 5;
    const size_t rowbase = (size_t)b * SEQ; const int q0 = qb * 256;
    LAS unsigned char* Kl = lds; LAS unsigned char* Vl = lds + 8192; LAS float* wsf = (LAS float*)(lds + 16384) + wid * 64; LAS bf16* stg = (LAS bf16*)(lds + 16384 + 2048) + wid * 2048;
    const bf16* Qw = proj + (rowbase + q0 + wid * 32) * NPROJ + PC_Q + h * 64;
    bf16x8 qr[4];
#pragma unroll
    for (int d0 = 0; d0 < 4; ++d0) qr[d0] = *(const bf16x8*)(Qw + (size_t)r32 * NPROJ + d0 * 16 + hi * 8);
    const int NT = 4 * (qb + 1);
    const bf16* ksrc = proj + (rowbase + lane) * NPROJ + PC_K + h * 64 + wid * 8;
    const bf16* vsrc = proj + (rowbase + 16 * (wid & 3) + (lane >> 2)) * NPROJ + PC_V + h * 64 + (wid >> 2) * 32 + (lane & 3) * 8;
    const u64* bmq = bm + (rowbase + q0 + wid * 32 + r32) * 64;
    const LAS unsigned char* vb = Vl + ((lane >> 4) & 1) * 32 + (lane & 3) * 8 + (4 * hi + ((lane & 15) >> 2)) * 64;
    float m = -1e30f, l = 0.f; f32x16 o0, o1;
#pragma unroll
    for (int i = 0; i < 16; ++i) { o0[i] = 0.f; o1[i] = 0.f; }
    v4u kreg = *(const v4u*)ksrc, vreg = *(const v4u*)vsrc, mw4 = {0u, 0u, 0u, 0u};
    for (int t = 0; t < NT; ++t) {
        __syncthreads();
        *(LAS v4u*)(Kl + wid * 1024 + lane * 16) = kreg; *(LAS v4u*)(Vl + wid * 1024 + lane * 16) = vreg;
        __syncthreads();
        if (t + 1 < NT) { kreg = *(const v4u*)(ksrc + (size_t)(t + 1) * 64 * NPROJ); vreg = *(const v4u*)(vsrc + (size_t)(t + 1) * 64 * NPROJ); }
        if ((t & 1) == 0) mw4 = *(const v4u*)(bmq + t);
        unsigned lo = (t & 1) ? mw4.z : mw4.x, hw = (t & 1) ? mw4.w : mw4.y;
        lo >>= 4 * hi; hw >>= 4 * hi;
        f32x16 c0, c1;
#pragma unroll
        for (int r = 0; r < 16; ++r) { const int bp = (r & 3) + 8 * (r >> 2); c0[r] = ((lo >> bp) & 1u) ? 0.f : -1e30f; c1[r] = ((hw >> bp) & 1u) ? 0.f : -1e30f; }
#pragma unroll
        for (int d0 = 0; d0 < 4; ++d0) {
            const bf16x8 k0 = *(const LAS bf16x8*)(Kl + (2 * d0 + hi) * 1024 + r32 * 16), k1 = *(const LAS bf16x8*)(Kl + (2 * d0 + hi) * 1024 + r32 * 16 + 512);
            c0 = __builtin_amdgcn_mfma_f32_32x32x16_bf16(k0, qr[d0], c0, 0, 0, 0); c1 = __builtin_amdgcn_mfma_f32_32x32x16_bf16(k1, qr[d0], c1, 0, 0, 0);
        }
        float rm = __builtin_fmaxf(c0[0], c1[0]);
#pragma unroll
        for (int r = 1; r < 16; ++r) rm = __builtin_fmaxf(rm, __builtin_fmaxf(c0[r], c1[r]));
        rm = __builtin_fmaxf(rm, __shfl_xor(rm, 32));
        const float mn = __builtin_fmaxf(m, rm); const float alpha = __builtin_amdgcn_exp2f(m - mn);
        m = mn; l *= alpha;
        if (__any(alpha != 1.0f)) {
            if (hi == 0) wsf[r32] = alpha;
#pragma unroll
            for (int r = 0; r < 16; ++r) { const float f = wsf[crow(r, hi)]; o0[r] *= f; o1[r] *= f; }
        }
        float ps = 0.f;
#pragma unroll
        for (int r = 0; r < 16; ++r) { c0[r] = __builtin_amdgcn_exp2f(c0[r] - mn); c1[r] = __builtin_amdgcn_exp2f(c1[r] - mn); ps += c0[r] + c1[r]; }
        l += ps;
        v4u pw[4];
#pragma unroll
        for (int ks = 0; ks < 2; ++ks) {
            pw[ks] = (v4u){cvtpk(c0[8 * ks + 0], c0[8 * ks + 1]), cvtpk(c0[8 * ks + 2], c0[8 * ks + 3]), cvtpk(c0[8 * ks + 4], c0[8 * ks + 5]), cvtpk(c0[8 * ks + 6], c0[8 * ks + 7])};
            pw[2 + ks] = (v4u){cvtpk(c1[8 * ks + 0], c1[8 * ks + 1]), cvtpk(c1[8 * ks + 2], c1[8 * ks + 3]), cvtpk(c1[8 * ks + 4], c1[8 * ks + 5]), cvtpk(c1[8 * ks + 6], c1[8 * ks + 7])};
        }
#pragma unroll
        for (int ks = 0; ks < 4; ++ks) {
            const s16x4 a0 = vtr(vb + ks * 1024), a1 = vtr(vb + ks * 1024 + 512), b0 = vtr(vb + 4096 + ks * 1024), b1 = vtr(vb + 4096 + ks * 1024 + 512);
            const bf16x8 v0 = (bf16x8){a0[0], a0[1], a0[2], a0[3], a1[0], a1[1], a1[2], a1[3]}, v1 = (bf16x8){b0[0], b0[1], b0[2], b0[3], b1[0], b1[1], b1[2], b1[3]};
            const bf16x8 pa = __builtin_bit_cast(bf16x8, pw[ks]);
            o0 = __builtin_amdgcn_mfma_f32_32x32x16_bf16(pa, v0, o0, 0, 0, 0); o1 = __builtin_amdgcn_mfma_f32_32x32x16_bf16(pa, v1, o1, 0, 0, 0);
        }
    }
    l += __shfl_xor(l, 32);
    if (hi == 0) wsf[32 + r32] = l;
#pragma unroll
    for (int r = 0; r < 16; ++r) { const float rl = __builtin_amdgcn_rcpf(wsf[32 + crow(r, hi)]); const int orow = crow(r, hi);
        stg[orow * 64 + r32] = (bf16)f2bf(o0[r] * rl); stg[orow * 64 + 32 + r32] = (bf16)f2bf(o1[r] * rl); }
    bf16* Ow = attn + (rowbase + q0 + wid * 32) * DA + h * 64;
#pragma unroll
    for (int i = 0; i < 4; ++i) { const int row = i * 8 + (lane >> 3), ch = lane & 7; const v4u v = *(const LAS v4u*)(stg + row * 64 + ch * 8); *(v4u*)(Ow + (size_t)row * DA + ch * 8) = v; }
}
__device__ __forceinline__ void phase4(const Params& p, LAS unsigned char* lds, int vcu, int tid, int wid, int lane) {
    for (int v = vcu; v < 256; v += gridDim.x) {
        const int bh = v >> 2, s = v & 3;
#pragma unroll 1
        for (int i = 0; i < 4; ++i) { const int qb = (i == 0) ? s : (i == 1) ? 7 - s : (i == 2) ? 8 + s : 15 - s; attn_unit(p, lds, bh >> 3, bh & 7, qb, tid, wid, lane); }
    }
}

template <bool WB> __device__ __forceinline__ void ln_rows(const float* src, float* dst, bf16* dstb, const float* g, const float* bta, int gw, int NGW, int lane) {
    f32x4 gv[4], bv[4];
#pragma unroll
    for (int j = 0; j < 4; ++j) { gv[j] = ((const f32x4*)g)[lane + 64 * j]; bv[j] = ((const f32x4*)bta)[lane + 64 * j]; }
    for (int m = gw; m < M; m += NGW) {
        const f32x4* xr = (const f32x4*)(src + (size_t)m * DM) + lane; f32x4 v[4]; float s = 0.f;
#pragma unroll
        for (int j = 0; j < 4; ++j) { v[j] = xr[64 * j]; s += (v[j][0] + v[j][1]) + (v[j][2] + v[j][3]); }
        const float mean = wave_sum(s) * (1.f / DM); float s2 = 0.f;
#pragma unroll
        for (int j = 0; j < 4; ++j) { v[j] = v[j] - mean; s2 += (v[j][0] * v[j][0] + v[j][1] * v[j][1]) + (v[j][2] * v[j][2] + v[j][3] * v[j][3]); }
        const float rstd = 1.f / sqrtf(wave_sum(s2) * (1.f / DM) + LN_EPS);
        f32x4* orow = (f32x4*)(dst + (size_t)m * DM) + lane;
#pragma unroll
        for (int j = 0; j < 4; ++j) { const f32x4 y = v[j] * rstd * gv[j] + bv[j]; orow[64 * j] = y;
            if (WB) ((u64*)(dstb + (size_t)m * DM))[lane + 64 * j] = (u64)pk2(y[0], y[1]) | ((u64)pk2(y[2], y[3]) << 32); }
    }
}

#define XB_TMO      128
#define XB_XCNT(j)  (256  + 64 * (j))
#define XB_XSUB(j)  (1280 + 64 * (j))
#define XB_XGEN(j)  (2304 + 64 * (j))
#define XB_TOP      3328
#define XB_TOPGEN   3392
#define XCD_BAR_WORDS 3456
#define XB_SPIN_CAP (1u << 18)

__device__ __forceinline__ unsigned xb_ld(unsigned* p)              { return __hip_atomic_load(p, __ATOMIC_RELAXED, __HIP_MEMORY_SCOPE_AGENT); }
__device__ __forceinline__ unsigned xb_add(unsigned* p, unsigned v) { return __hip_atomic_fetch_add(p, v, __ATOMIC_RELAXED, __HIP_MEMORY_SCOPE_AGENT); }
__device__ __forceinline__ unsigned xb_xcc_id() { return (unsigned)__builtin_amdgcn_s_getreg((3 << 11) | 20) & 0xFu; }
#define XB_SPIN(cond, bar) do { unsigned _sp = 0; while (cond) { __builtin_amdgcn_s_sleep(1); \
    if ((++_sp & 255u) == 0u) { if (xb_ld(&(bar)[XB_TMO])) break; if (_sp > XB_SPIN_CAP) { atomicAdd(&(bar)[XB_TMO], 1u); break; } } } } while (0)

struct XcdBarrier {
    unsigned* bar; unsigned x;
    volatile LAS unsigned* st;
};

__device__ __forceinline__ XcdBarrier xcd_barrier_post(unsigned* bar, volatile LAS unsigned* st) {
    XcdBarrier b; b.bar = bar; b.x = xb_xcc_id(); b.st = st;
    if (threadIdx.x == 0) (void)xb_add(&bar[XB_XCNT(b.x)], 1u);
    return b;
}
__device__ __forceinline__ void xcd_barrier_complete(unsigned* bar, unsigned x, unsigned& nloc, unsigned& nx) {
    const unsigned G = gridDim.x * gridDim.y * gridDim.z;
    unsigned sum, cnt, mine, sp = 0u;
    for (;;) {
        sum = 0u; cnt = 0u; mine = 0u;
#pragma unroll
        for (unsigned j = 0; j < 16; ++j) { const unsigned c = xb_ld(&bar[XB_XCNT(j)]); sum += c; cnt += (c > 0u) ? 1u : 0u; mine = (j == x) ? c : mine; }
        if (sum == G) break;
        __builtin_amdgcn_s_sleep(1);
        if ((++sp & 255u) == 0u) { if (xb_ld(&bar[XB_TMO])) break; if (sp > XB_SPIN_CAP) { atomicAdd(&bar[XB_TMO], 1u); break; } }
    }
    nloc = mine > 0u ? mine : 1u; nx = cnt > 0u ? cnt : 1u;
}

__device__ __forceinline__ void xcd_barrier(const XcdBarrier& b) {
    asm volatile("s_waitcnt vmcnt(0)" ::: "memory");
    __syncthreads();
    if (threadIdx.x == 0) {
        unsigned* bar = b.bar;
        __builtin_amdgcn_s_waitcnt(0);
        unsigned nloc = b.st[0], nx = b.st[1];
        if (nloc == 0u) { xcd_barrier_complete(bar, b.x, nloc, nx); b.st[0] = nloc; b.st[1] = nx; }
        const unsigned old = xb_add(&bar[XB_XSUB(b.x)], 1u);
        const unsigned gen = old / nloc;
        if (old + 1u == (gen + 1u) * nloc) {
            __builtin_amdgcn_fence(__ATOMIC_RELEASE, "agent");
            asm volatile("s_waitcnt vmcnt(0)" ::: "memory");
            const unsigned og = xb_add(&bar[XB_TOP], 1u);
            const unsigned tg = og / nx;
            if (og + 1u == (tg + 1u) * nx) xb_add(&bar[XB_TOPGEN], 1u);
            else XB_SPIN(xb_ld(&bar[XB_TOPGEN]) == tg, bar);
            __builtin_amdgcn_fence(__ATOMIC_ACQUIRE, "agent");
            xb_add(&bar[XB_XGEN(b.x)], 1u);
            asm volatile("s_waitcnt vmcnt(0)" ::: "memory");
        } else {
            XB_SPIN(xb_ld(&bar[XB_XGEN(b.x)]) == gen, bar);
            __builtin_amdgcn_fence(__ATOMIC_ACQUIRE, "agent");
            asm volatile("s_waitcnt vmcnt(0)" ::: "memory");
        }
    }
    __syncthreads();
}

__global__ void __launch_bounds__(NTHREADS, 2) fwd_kernel(Params p) {
    extern __shared__ __attribute__((aligned(16))) unsigned char lds_raw[];
    cg::grid_group grid = cg::this_grid();
    LAS unsigned char* lds = (LAS unsigned char*)lds_raw;
    const int tid = threadIdx.x, lane = tid & 63, wave = __builtin_amdgcn_readfirstlane(tid >> 6);
    const int G = gridDim.x, bid = blockIdx.x;
    const int vcu = (G % 8 == 0) ? (bid % 8) * (G / 8) + bid / 8 : bid;
    const int gw = vcu * NWAVES + wave, NGW = G * NWAVES;
    unsigned char* ws = p.ws;
    bf16* proj = (bf16*)(ws + WS_PROJ);
    volatile LAS unsigned* MISC = (volatile LAS unsigned*)(lds + MISC_OFF);
    if (tid < 32) MISC[tid] = 0u;
    __syncthreads();
    XcdBarrier bar = xcd_barrier_post((unsigned*)(ws + WS_CTL) + CW_BAR, MISC + 8);

    phase0(p, lds, gw, NGW, wave, lane);
    grid.sync();
    {
        pg8::Gemm g{(const bf16*)(ws + WS_XB), (const bf16*)(ws + WS_WIN), M, NPROJ, DM}; pg8::StaticOrder S; S.init(M, NPROJ, G, bid);
        pg8::EpiBf16<0> E{proj, NPROJ};
        pg8::gemm_phase<pg8::EpiBf16<0>, pg8::StaticOrder, true, true>(lds, g, S, E);
    }
    xcd_barrier(bar);
    phase2a(p, gw, NGW, lane);
    phase2b(p, lds, vcu, G, tid, wave, lane);
    xcd_barrier(bar);
    phase3(p, lds, vcu, G, tid, wave, lane);
    xcd_barrier(bar);
    phase4(p, lds, vcu, tid, wave, lane);
    xcd_barrier(bar);
    {
        pg8::Gemm g{(const bf16*)(ws + WS_CU), (const bf16*)(ws + WS_WCO), M, DM, DC}; pg8::StaticOrder S; S.init(M, DM, G, bid);
        pg8::EpiGate1 E{p.out, proj + PC_GC, NPROJ, p.gate_b};
        pg8::gemm_phase<pg8::EpiGate1, pg8::StaticOrder, true, true>(lds, g, S, E);
    }
    __syncthreads();
    {
        pg8::Gemm g{(const bf16*)(ws + WS_AT), (const bf16*)(ws + WS_WAO), M, DM, DA}; pg8::StaticOrder S; S.init(M, DM, G, bid);
        pg8::EpiGate2 E{p.out, (bf16*)(ws + WS_XB), proj + PC_GA, NPROJ, p.gate_b + DM};
        pg8::gemm_phase<pg8::EpiGate2, pg8::StaticOrder, true, true>(lds, g, S, E);
    }
    xcd_barrier(bar);
    {
        pg8::Gemm g{(const bf16*)(ws + WS_XB), (const bf16*)(ws + WS_WO), M, DM, DM}; pg8::StaticOrder S; S.init(M, DM, G, bid);
        pg8::EpiResid E{p.x, p.out, DN_ALPHA};
        pg8::gemm_phase<pg8::EpiResid, pg8::StaticOrder, true, true>(lds, g, S, E);
    }
    xcd_barrier(bar);
    ln_rows<true>(p.out, (float*)(ws + WS_X1), (bf16*)(ws + WS_X1B), p.ln1_g, p.ln1_b, gw, NGW, lane);
    xcd_barrier(bar);
    {
        pg8::Gemm g{(const bf16*)(ws + WS_X1B), (const bf16*)(ws + WS_WF1), M, FF, DM}; pg8::StaticOrder S; S.init(M, FF, G, bid);
        pg8::EpiBf16<2> E{(bf16*)(ws + WS_H), FF};
        pg8::gemm_phase<pg8::EpiBf16<2>, pg8::StaticOrder, true, true>(lds, g, S, E);
    }
    xcd_barrier(bar);
    {
        pg8::Gemm g{(const bf16*)(ws + WS_H), (const bf16*)(ws + WS_WF2), M, DM, FF}; pg8::StaticOrder S; S.init(M, DM, G, bid);
        pg8::EpiResid E{(const float*)(ws + WS_X1), p.out, DN_ALPHA};
        pg8::gemm_phase<pg8::EpiResid, pg8::StaticOrder, true, true>(lds, g, S, E);
    }
    xcd_barrier(bar);
    ln_rows<false>(p.out, p.out, nullptr, p.ln2_g, p.ln2_b, gw, NGW, lane);
}

extern "C" void kernel_launch(void* const* d_in, const int* in_sizes, int n_in, void* d_out, int out_size, void* d_ws, size_t ws_size, hipStream_t stream) {
    static int grid = 0;
    if (grid == 0) {
        if (n_in != 18 || in_sizes[0] != M * DM || out_size != M * DM || ws_size < WS_END) { fprintf(stderr, "kernel_launch: unexpected shapes (n_in %d, in0 %d, out %d, ws %zu)\n", n_in, n_in > 0 ? in_sizes[0] : -1, out_size, ws_size); grid = -1; return; }
        int dev = 0, cus = 0, per_cu = 0;
        if (hipGetDevice(&dev) != hipSuccess || hipDeviceGetAttribute(&cus, hipDeviceAttributeMultiprocessorCount, dev) != hipSuccess) { grid = -1; return; }
        if (hipFuncSetAttribute((const void*)fwd_kernel, hipFuncAttributeMaxDynamicSharedMemorySize, LDS_BYTES) != hipSuccess) { fprintf(stderr, "kernel_launch: hipFuncSetAttribute failed\n"); grid = -1; return; }
        if (hipOccupancyMaxActiveBlocksPerMultiprocessor(&per_cu, (const void*)fwd_kernel, NTHREADS, LDS_BYTES) != hipSuccess || per_cu < 1) { fprintf(stderr, "kernel_launch: occupancy query says %d\n", per_cu); (void)hipGetLastError(); per_cu = 1; }
        grid = cus * per_cu;
    }
    if (grid < 0) return;
    if (hipMemsetAsync((char*)d_ws + WS_CTL, 0, CTL_ZERO_BYTES, stream) != hipSuccess) { fprintf(stderr, "kernel_launch: hipMemsetAsync failed\n"); return; }
    Params p{};
    p.x = (const float*)d_in[0]; p.w_in = (const float*)d_in[1]; p.dw_w = (const float*)d_in[2]; p.dw_b = (const float*)d_in[3]; p.cln_g = (const float*)d_in[4]; p.cln_b = (const float*)d_in[5];
    p.w_co = (const float*)d_in[6]; p.kln_g = (const float*)d_in[7]; p.kln_b = (const float*)d_in[8]; p.w_ao = (const float*)d_in[9]; p.gate_b = (const float*)d_in[10]; p.w_o = (const float*)d_in[11];
    p.ln1_g = (const float*)d_in[12]; p.ln1_b = (const float*)d_in[13]; p.w_f1 = (const float*)d_in[14]; p.w_f2 = (const float*)d_in[15]; p.ln2_g = (const float*)d_in[16]; p.ln2_b = (const float*)d_in[17];
    p.out = (float*)d_out; p.ws = (unsigned char*)d_ws;
    void* args[] = {&p};
    hipError_t e = hipLaunchCooperativeKernel((const void*)fwd_kernel, dim3(grid), dim3(NTHREADS), args, LDS_BYTES, stream);
    if (e != hipSuccess) fprintf(stderr, "kernel_launch: cooperative launch failed: %s (grid %d)\n", hipGetErrorString(e), grid);
}
```
